# Optimizing an MI355X kernel written in HIP

```python
import functools
import jax, jax.numpy as jnp
from jax import lax
import numpy as np

D_MODEL = 1024
BATCH = 8
SEQ = 2048
DEPTH = 4
DEC_BATCH = 128
DEC_SEQ = 4
PAST_LEN = 2048
PAGE_SIZE = 128

N_A_LAYERS = DEPTH // 2
N_B_LAYERS = DEPTH - N_A_LAYERS
GLA_HEADS = 4
GLA_QK = D_MODEL // 2
GLA_V = D_MODEL
GLA_DK = GLA_QK // GLA_HEADS
GLA_DV = GLA_V // GLA_HEADS
GLA_LR = 16
GLA_TAU = 16.0
GLA_CHUNK = 64
GLA_IN = 2 * GLA_QK + 2 * GLA_V + GLA_LR
HEAD_DIM = 128
N_KV = 4
Q_PER_KV = 2
N_QH_GROUP = N_KV * Q_PER_KV
DIL_GROUPS = ((128, 1), (512, 4), (2048, 16))
N_GROUPS = len(DIL_GROUPS)
MAX_WINDOW = max(w for w, _ in DIL_GROUPS)
ROPE_DIM = HEAD_DIM // 4
ROPE_THETA = 500000.0
FFN_HIDDEN = ((8 * D_MODEL + 3 * 256 - 1) // (3 * 256)) * 256
PLE_DIM = 256
EPS = 1e-6
NEG_INF = -1e30

kernel_name = 'yoco_gla_dilated_swa_decode_step'


def rms_norm(x, g):
    xf = x.astype(jnp.float32)
    y = xf * lax.rsqrt(jnp.mean(xf * xf, axis=-1, keepdims=True) + EPS)
    return (y * g.astype(jnp.float32)).astype(x.dtype)


def rope_partial(x, pos):
    half = ROPE_DIM // 2
    freqs = jnp.power(ROPE_THETA, -jnp.arange(half, dtype=jnp.float32) * 2.0 / ROPE_DIM)
    ang = pos[:, None] * freqs[None, :]
    shape = (ang.shape[0],) + (1,) * (x.ndim - 3) + (half,)
    cos = jnp.cos(ang).reshape(shape)
    sin = jnp.sin(ang).reshape(shape)
    xf = x.astype(jnp.float32)
    x1 = xf[..., :half]
    x2 = xf[..., half:ROPE_DIM]
    out = jnp.concatenate([x1 * cos - x2 * sin, x2 * cos + x1 * sin, xf[..., ROPE_DIM:]], axis=-1)
    return out.astype(x.dtype)


def gla_chunked(q, k, v, log_a, s0):
    B, L, H, DK = q.shape
    DV = v.shape[-1]
    C = GLA_CHUNK if L % GLA_CHUNK == 0 else L
    n = L // C

    def blocks(t):
        return t.reshape(B, n, C, H, t.shape[-1]).transpose(1, 0, 3, 2, 4)

    qb, kb, vb, gb = blocks(q), blocks(k), blocks(v), blocks(log_a)
    cum = jnp.cumsum(gb, axis=3)
    last = cum[:, :, :, -1:, :]
    q_in = qb * jnp.exp(cum)
    k_in = kb * jnp.exp(-cum)
    k_end = kb * jnp.exp(last - cum)
    causal = jnp.tril(jnp.ones((C, C), dtype=bool))
    att = jnp.where(causal, jnp.einsum('nbhcd,nbhsd->nbhcs', q_in, k_in), 0.0)
    o_intra = jnp.einsum('nbhcs,nbhsv->nbhcv', att, vb)
    decay = jnp.exp(last[:, :, :, 0, :])

    def step(s, inp):
        qi, ke, vi, dc = inp
        o = jnp.einsum('bhcd,bhdv->bhcv', qi, s)
        s = dc[..., None] * s + jnp.einsum('bhcd,bhcv->bhdv', ke, vi)
        return s, o

    s_fin, o_inter = lax.scan(step, s0, (q_in, k_end, vb, decay))
    o = (o_intra + o_inter).transpose(1, 0, 3, 2, 4).reshape(B, L, H, DV)
    return o, s_fin


def gla_mixer(h, w_in, w_gk_up, b_gk, onorm, w_o, s0):
    B, L, _ = h.shape
    proj = h @ w_in
    q, k, v, r, glr = jnp.split(proj, [GLA_QK, 2 * GLA_QK, 2 * GLA_QK + GLA_V, 2 * GLA_QK + 2 * GLA_V], axis=-1)
    log_a = jax.nn.log_sigmoid((glr @ w_gk_up + b_gk).astype(jnp.float32)) / GLA_TAU

    def heads(t, d):
        return t.astype(jnp.float32).reshape(B, L, GLA_HEADS, d)

    o, s_new = gla_chunked(heads(q, GLA_DK) * (GLA_DK ** -0.5), heads(k, GLA_DK), heads(v, GLA_DV),
                           log_a.reshape(B, L, GLA_HEADS, GLA_DK), s0.astype(jnp.float32))
    o = rms_norm(o, onorm) * jax.nn.silu(r.astype(jnp.float32)).reshape(B, L, GLA_HEADS, GLA_DV)
    return o.reshape(B, L, GLA_V).astype(h.dtype) @ w_o, s_new


def dilated_band_attention(q, win, dil, k, v):
    B, L = q.shape[:2]
    n = win // dil
    M = L // dil
    nb = -(-M // n)
    Mp = nb * n

    def by_class(t):
        return jnp.moveaxis(t.reshape((B, M, dil) + t.shape[2:]), 2, 1)

    qc = jnp.pad(by_class(q), ((0, 0), (0, 0), (0, Mp - M), (0, 0), (0, 0), (0, 0)))
    qb = qc.reshape(B, dil, nb, n, N_KV, Q_PER_KV, HEAD_DIM)

    def band_keys(t):
        t = jnp.pad(by_class(t), ((0, 0), (0, 0), (n, Mp - M), (0, 0), (0, 0))).reshape(B, dil, nb + 1, n, N_KV, HEAD_DIM)
        return jnp.concatenate([t[:, :, :-1], t[:, :, 1:]], axis=3)

    kb, vb = band_keys(k), band_keys(v)
    s = jnp.einsum('bcnikgd,bcnjkd->bcnkgij', qb, kb, preferred_element_type=jnp.float32) * (HEAD_DIM ** -0.5)
    qi = jnp.arange(nb)[:, None, None] * n + jnp.arange(n)[None, :, None]
    kj = jnp.arange(nb)[:, None, None] * n - n + jnp.arange(2 * n)[None, None, :]
    valid = (kj <= qi) & (kj >= qi - n) & (kj >= 0)
    s = jnp.where(valid[:, None, None], s, NEG_INF)
    lse = jax.nn.logsumexp(s, axis=-1)
    p = jnp.exp(s - lse[..., None])
    o = jnp.einsum('bcnkgij,bcnjkd->bcnikgd', p, vb, preferred_element_type=jnp.float32)
    o = o.reshape(B, dil, Mp, N_KV, Q_PER_KV, HEAD_DIM)[:, :, :M]
    o = jnp.moveaxis(o, 1, 2).reshape(B, L, N_KV, Q_PER_KV, HEAD_DIM)
    lse = jnp.moveaxis(lse, -1, 3).reshape(B, dil, Mp, N_KV, Q_PER_KV)[:, :, :M]
    lse = jnp.moveaxis(lse, 1, 2).reshape(B, L, N_KV, Q_PER_KV)
    return o, lse


def dilated_gather_attention(q, win, dil, k_all, v_all):
    T = q.shape[1]
    S = k_all.shape[1]
    n = win // dil
    idx = (S - T) + jnp.arange(T)[:, None] - dil * jnp.arange(n + 1)[None, :]
    valid = idx >= 0
    idx = jnp.maximum(idx, 0)
    kg = jnp.take(k_all, idx, axis=1)
    vg = jnp.take(v_all, idx, axis=1)
    s = jnp.einsum('btkgd,btikd->btkgi', q, kg, preferred_element_type=jnp.float32) * (HEAD_DIM ** -0.5)
    s = jnp.where(valid[:, None, None, :], s, NEG_INF)
    lse = jax.nn.logsumexp(s, axis=-1)
    p = jnp.exp(s - lse[..., None])
    o = jnp.einsum('btkgi,btikd->btkgd', p, vg, preferred_element_type=jnp.float32)
    return o, lse


def dilated_mixer(h, w_q, q_norm, w_o, pos, attend):
    B, L, _ = h.shape
    q = (h @ w_q).reshape(B, L, N_GROUPS, N_KV, Q_PER_KV, HEAD_DIM)
    q = rope_partial(rms_norm(q, q_norm), pos)
    outs, lses = [], []
    for g, (win, dil) in enumerate(DIL_GROUPS):
        o, l = attend(q[:, :, g], win, dil)
        outs.append(o)
        lses.append(l)
    w = jax.nn.softmax(jnp.stack(lses), axis=0)
    o = jnp.sum(w[..., None] * jnp.stack(outs), axis=0)
    return o.reshape(B, L, N_QH_GROUP * HEAD_DIM).astype(h.dtype) @ w_o


def shared_kv(x, kv_norm, w_kv, k_norm, pos):
    B, L, _ = x.shape
    kv = (rms_norm(x, kv_norm) @ w_kv).reshape(B, L, 2, N_KV, HEAD_DIM)
    k = rope_partial(rms_norm(kv[:, :, 0], k_norm), pos)
    return k, kv[:, :, 1]


def swiglu_ffn(x, g, w_in, w_out):
    a, b = jnp.split(rms_norm(x, g) @ w_in, 2, axis=-1)
    return (jax.nn.silu(a) * b) @ w_out


def per_layer_embed(x, p, g, w_proj, w_gate):
    return (p @ w_proj) * jax.nn.sigmoid(rms_norm(x, g) @ w_gate)


def run_trunk(x, p, gla_s0, k_past, v_past, pos, a_norm, a_w_in, a_w_gk_up, a_b_gk, a_onorm, a_w_o,
              kv_norm, w_kv, k_norm, b_norm, b_w_q, b_q_norm, b_w_o, f_norm, f_w_in, f_w_out,
              e_norm, e_w_proj, e_w_gate):
    gla_states = []
    k_new = v_new = attend = None
    for i in range(DEPTH):
        if i < N_A_LAYERS:
            h, s = gla_mixer(rms_norm(x, a_norm[i]), a_w_in[i], a_w_gk_up[i], a_b_gk[i], a_onorm[i], a_w_o[i], gla_s0[i])
            gla_states.append(s)
        else:
            j = i - N_A_LAYERS
            if j == 0:
                k_new, v_new = shared_kv(x, kv_norm, w_kv, k_norm, pos)
                if k_past is None:
                    attend = functools.partial(dilated_band_attention, k=k_new, v=v_new)
                else:
                    k_all = jnp.concatenate([k_past.astype(k_new.dtype), k_new], axis=1)
                    v_all = jnp.concatenate([v_past.astype(v_new.dtype), v_new], axis=1)
                    attend = functools.partial(dilated_gather_attention, k_all=k_all, v_all=v_all)
            h = dilated_mixer(rms_norm(x, b_norm[j]), b_w_q[j], b_q_norm[j], b_w_o[j], pos, attend)
        x = x + h.astype(x.dtype)
        x = x + swiglu_ffn(x, f_norm[i], f_w_in[i], f_w_out[i]).astype(x.dtype)
        x = x + per_layer_embed(x, p[i], e_norm[i], e_w_proj[i], e_w_gate[i]).astype(x.dtype)
    return x, jnp.stack(gla_states), k_new, v_new


def setup_inputs(seed: int = 0) -> dict:
    key = jax.random.key(seed)
    keys = iter(jax.random.split(key, 32))

    def nrm(shape, scale):
        return jax.random.normal(next(keys), shape, jnp.float32) * scale

    def gain(shape):
        return 1.0 + nrm(shape, 0.02)

    buf = min(MAX_WINDOW, PAST_LEN)
    return {
        'x_prompt': nrm((BATCH, SEQ, D_MODEL), 1.0),
        'x_sample': nrm((DEC_BATCH, DEC_SEQ, D_MODEL), 1.0),
        'p_prompt': nrm((DEPTH, BATCH, SEQ, PLE_DIM), 1.0),
        'p_sample': nrm((DEPTH, DEC_BATCH, DEC_SEQ, PLE_DIM), 1.0),
        'state_gla': nrm((N_A_LAYERS, DEC_BATCH, GLA_HEADS, GLA_DK, GLA_DV), 0.5),
        'cache_k': nrm((DEC_BATCH, buf, N_KV, HEAD_DIM), 1.0),
        'cache_v': nrm((DEC_BATCH, buf, N_KV, HEAD_DIM), 1.0),
        'a_norm': gain((N_A_LAYERS, D_MODEL)),
        'a_w_in': nrm((N_A_LAYERS, D_MODEL, GLA_IN), D_MODEL ** -0.5),
        'a_w_gk_up': nrm((N_A_LAYERS, GLA_LR, GLA_QK), GLA_LR ** -0.5),
        'a_b_gk': nrm((N_A_LAYERS, GLA_QK), 0.1),
        'a_onorm': gain((N_A_LAYERS, GLA_DV)),
        'a_w_o': nrm((N_A_LAYERS, GLA_V, D_MODEL), GLA_V ** -0.5),
        'kv_norm': gain((D_MODEL,)),
        'w_kv': nrm((D_MODEL, 2 * N_KV * HEAD_DIM), D_MODEL ** -0.5),
        'k_norm': gain((HEAD_DIM,)),
        'b_norm': gain((N_B_LAYERS, D_MODEL)),
        'b_w_q': nrm((N_B_LAYERS, D_MODEL, N_GROUPS * N_QH_GROUP * HEAD_DIM), D_MODEL ** -0.5),
        'b_q_norm': gain((N_B_LAYERS, HEAD_DIM)),
        'b_w_o': nrm((N_B_LAYERS, N_QH_GROUP * HEAD_DIM, D_MODEL), (N_QH_GROUP * HEAD_DIM) ** -0.5),
        'f_norm': gain((DEPTH, D_MODEL)),
        'f_w_in': nrm((DEPTH, D_MODEL, 2 * FFN_HIDDEN), D_MODEL ** -0.5),
        'f_w_out': nrm((DEPTH, FFN_HIDDEN, D_MODEL), FFN_HIDDEN ** -0.5),
        'e_norm': gain((DEPTH, D_MODEL)),
        'e_w_proj': nrm((DEPTH, PLE_DIM, D_MODEL), PLE_DIM ** -0.5),
        'e_w_gate': nrm((DEPTH, D_MODEL, D_MODEL), D_MODEL ** -0.5),
    }


def reference(x_prompt, x_sample, p_prompt, p_sample, state_gla, cache_k, cache_v,
              a_norm, a_w_in, a_w_gk_up, a_b_gk, a_onorm, a_w_o, kv_norm, w_kv, k_norm,
              b_norm, b_w_q, b_q_norm, b_w_o, f_norm, f_w_in, f_w_out, e_norm, e_w_proj, e_w_gate):
    weights = (a_norm, a_w_in, a_w_gk_up, a_b_gk, a_onorm, a_w_o, kv_norm, w_kv, k_norm,
               b_norm, b_w_q, b_q_norm, b_w_o, f_norm, f_w_in, f_w_out, e_norm, e_w_proj, e_w_gate)
    seq = x_prompt.shape[1]
    dec_seq = x_sample.shape[1]
    pos_prompt = jnp.arange(seq, dtype=jnp.float32)
    pos_sample = PAST_LEN + jnp.arange(dec_seq, dtype=jnp.float32)
    s0 = jnp.zeros((N_A_LAYERS, x_prompt.shape[0], GLA_HEADS, GLA_DK, GLA_DV), jnp.float32)
    y_prompt, gla_state_prompt, k_p, v_p = run_trunk(x_prompt, p_prompt, s0, None, None, pos_prompt, *weights)
    y_sample, gla_state_sample, k_sample, v_sample = run_trunk(x_sample, p_sample, state_gla, cache_k, cache_v, pos_sample, *weights)
    keep = min(MAX_WINDOW, seq)
    k_prompt = k_p[:, seq - keep:]
    v_prompt = v_p[:, seq - keep:]
    return (y_prompt, y_sample, gla_state_prompt, gla_state_sample, k_prompt, v_prompt, k_sample, v_sample)
```

```cpp
#include <hip/hip_runtime.h>
#include <cstdio>
#include <cstdint>
#include <hip/hip_bf16.h>
#ifndef MK_ONE_LAUNCH
#define MK_ONE_LAUNCH 1
#endif
namespace pg8 {
#define PG8_LAS __attribute__((address_space(3)))
typedef unsigned short bf16_t;
typedef short bf16x8 __attribute__((ext_vector_type(8)));
typedef float f32x4 __attribute__((ext_vector_type(4)));
typedef unsigned u32x4 __attribute__((ext_vector_type(4)));
constexpr int BM = 256, BK = 64, HALF = 128, HTB = HALF * BK * 2  , STAGE_BYTES = 8 * HTB, NXCD = 8, WGM = 8;

__host__ __device__ __forceinline__ int lds_byte(int r, int c) { const int st = (r >> 4) * 2 + (c >> 5), rr = r & 15, cc = c & 31, ob = rr * 64 + cc * 2; return st * 1024 + (ob ^ (((ob >> 9) & 1) << 5)); }
__host__ __device__ __forceinline__ void stage_rc(int b, int& R, int& C) { const int st = b / 1024, sb = b % 1024, swz = sb ^ (((sb >> 9) & 1) << 5); R = (st >> 1) * 16 + swz / 64; C = (st & 1) * 32 + (swz % 64) / 2; }
__host__ __device__ __forceinline__ int perm32(int rho) { const int n = rho >> 4, i = rho & 15; return 8 * (i >> 2) + 4 * n + (i & 3); }

struct Unit { int pm, pn; };
struct Gemm { const bf16_t* A; const bf16_t* Bt; int M, N, K; };

struct StaticOrder {
    int nM, nN, nwg, G, c;
    __host__ __device__ void init(int M, int N, int G_, int c_) { nM = M / BM; nN = N / BM; nwg = nM * nN; G = G_; c = c_; }
    __host__ __device__ bool next(int i, Unit& u) const {
        const long L = (long)i * G + c; if (L >= nwg) return false;
        int wgid = (int)L; { const int q = nwg / NXCD, r = nwg % NXCD, xcd = wgid % NXCD, off = wgid / NXCD; wgid = (xcd < r ? xcd * (q + 1) : r * (q + 1) + (xcd - r) * q) + off; }
        const int nig = WGM * nN, gid = wgid / nig, fm = gid * WGM, gsz = (nM - fm) < WGM ? (nM - fm) : WGM;
        u.pm = fm + ((wgid % nig) % gsz); u.pn = (wgid % nig) / gsz; return true;
    }
    __device__ __forceinline__ void a_ready(const Unit&) const {}
    __device__ __forceinline__ void done(const Unit&) const {}
};
__device__ __forceinline__ unsigned cvt_pk_bf16(float lo, float hi) { unsigned r; asm volatile("v_cvt_pk_bf16_f32 %0, %1, %2" : "=v"(r) : "v"(lo), "v"(hi)); return r; }
constexpr float RMS_EPS = 1e-6f;
__device__ __forceinline__ float rstd_of(const float* ssq16, int r) { const f32x4* p = (const f32x4*)(ssq16 + (size_t)r * 16); const f32x4 a = p[0], b = p[1], c = p[2], d = p[3];
    const float t = ((a[0] + a[1]) + (a[2] + a[3])) + ((b[0] + b[1]) + (b[2] + b[3])) + (((c[0] + c[1]) + (c[2] + c[3])) + ((d[0] + d[1]) + (d[2] + d[3])));
    return __builtin_amdgcn_rsqf(t * (1.0f / 1024.0f) + RMS_EPS); }
__device__ __forceinline__ float fast_sigmoid(float x) { return __builtin_amdgcn_rcpf(1.0f + __expf(-x)); }

struct EpiScale {
    static constexpr bool PERM = true, AFTER_DRAIN = false;
    bf16_t* O; int ldc; const float* ssq; int pn_f32; float* F; int ldf;
    __device__ __forceinline__ void operator()(const f32x4 (&acc)[2][2][4][2], const Unit& u, int wr, int wc, int fr, int fq) const {
        const int row0 = u.pm * BM + wr * 64 + fr;
        const bool tof32 = u.pn >= pn_f32;
        const int col0 = (tof32 ? (u.pn - pn_f32) : u.pn) * BM + wc * 32 + 8 * fq;
#pragma unroll
        for (int ai = 0; ai < 2; ++ai)
#pragma unroll
            for (int m = 0; m < 4; ++m) { const int r = row0 + ai * HALF + m * 16; const float s = ssq ? rstd_of(ssq, r) : 1.0f;
#pragma unroll
                for (int bj = 0; bj < 2; ++bj) { const f32x4 v0 = acc[ai][bj][m][0] * s, v1 = acc[ai][bj][m][1] * s;
                    if (tof32) { float* p = F + (size_t)r * ldf + col0 + bj * HALF; *(f32x4*)p = v0; *(f32x4*)(p + 4) = v1; }
                    else { u32x4 w; w.x = cvt_pk_bf16(v0[0], v0[1]); w.y = cvt_pk_bf16(v0[2], v0[3]); w.z = cvt_pk_bf16(v1[0], v1[1]); w.w = cvt_pk_bf16(v1[2], v1[3]);
                        *(u32x4*)(O + (size_t)r * ldc + col0 + bj * HALF) = w; } } }
    }
};
struct EpiSwiglu {
    static constexpr bool PERM = true, AFTER_DRAIN = false;
    bf16_t* H; int ldh; const float* ssq;
    __device__ __forceinline__ void operator()(const f32x4 (&acc)[2][2][4][2], const Unit& u, int wr, int wc, int fr, int fq) const {
        const int row0 = u.pm * BM + wr * 64 + fr, col0 = u.pn * HALF + wc * 32 + 8 * fq;
#pragma unroll
        for (int ai = 0; ai < 2; ++ai)
#pragma unroll
            for (int m = 0; m < 4; ++m) { const int r = row0 + ai * HALF + m * 16; const float s = rstd_of(ssq, r);
                float h[8];
#pragma unroll
                for (int n = 0; n < 2; ++n)
#pragma unroll
                    for (int j = 0; j < 4; ++j) { const float a = acc[ai][0][m][n][j] * s, b = acc[ai][1][m][n][j] * s; h[n * 4 + j] = a * fast_sigmoid(a) * b; }
                u32x4 w; w.x = cvt_pk_bf16(h[0], h[1]); w.y = cvt_pk_bf16(h[2], h[3]); w.z = cvt_pk_bf16(h[4], h[5]); w.w = cvt_pk_bf16(h[6], h[7]);
                *(u32x4*)(H + (size_t)r * ldh + col0) = w; }
    }
};
template <int MODE> struct EpiRes {
    static constexpr bool PERM = false, AFTER_DRAIN = false;
    const bf16_t* Xin; bf16_t* XBo; float* ssq_out; const float* ssq_in; const bf16_t* PP; float* Yf;
    __device__ __forceinline__ void operator()(const f32x4 (&acc)[2][2][4][2], const Unit& u, int wr, int wc, int fr, int fq) const {
        typedef unsigned u32x2 __attribute__((ext_vector_type(2)));
        const int row0 = u.pm * BM + wr * 64 + fr, col0 = u.pn * BM + wc * 32 + 4 * fq;
#pragma unroll
        for (int ai = 0; ai < 2; ++ai)
#pragma unroll
            for (int m = 0; m < 4; ++m) { const int r = row0 + ai * HALF + m * 16; float ss = 0.f; float s = 1.f; if (MODE == 1) s = rstd_of(ssq_in, r);
#pragma unroll
                for (int bj = 0; bj < 2; ++bj)
#pragma unroll
                    for (int n = 0; n < 2; ++n) { const size_t off = (size_t)r * 1024 + col0 + bj * HALF + n * 16;
                        const u32x2 xw = *(const u32x2*)(Xin + off);
                        f32x4 xv = (f32x4){__uint_as_float(xw.x << 16), __uint_as_float(xw.x & 0xffff0000u), __uint_as_float(xw.y << 16), __uint_as_float(xw.y & 0xffff0000u)};
                        f32x4 d = acc[ai][bj][m][n];
                        if (MODE == 1) { const u32x2 pw = *(const u32x2*)(PP + off);
                            const float p0 = __uint_as_float(pw.x << 16), p1 = __uint_as_float(pw.x & 0xffff0000u), p2 = __uint_as_float(pw.y << 16), p3 = __uint_as_float(pw.y & 0xffff0000u);
                            d = (f32x4){p0 * fast_sigmoid(d[0] * s), p1 * fast_sigmoid(d[1] * s), p2 * fast_sigmoid(d[2] * s), p3 * fast_sigmoid(d[3] * s)}; }
                        xv = xv + d;
                        if (Yf) __builtin_nontemporal_store(xv, (f32x4*)(Yf + off));
                        u32x2 w; w.x = cvt_pk_bf16(xv[0], xv[1]); w.y = cvt_pk_bf16(xv[2], xv[3]); *(u32x2*)(XBo + off) = w;
                        ss += (xv[0] * xv[0] + xv[1] * xv[1]) + (xv[2] * xv[2] + xv[3] * xv[3]); }
                ss += __shfl_xor(ss, 16); ss += __shfl_xor(ss, 32);
                if (fq == 0) ssq_out[(size_t)r * 16 + u.pn * 4 + wc] = ss; }
    }
};
template <class Epi, class Sched, bool ALIGN_EPI = false, bool SP2 = false>
__device__ __forceinline__ void gemm_phase(PG8_LAS unsigned char* lds, const Gemm g, const Sched& S, const Epi& E) {
    const int tid = threadIdx.x, wid = __builtin_amdgcn_readfirstlane(tid >> 6), lane = tid & 63, wr = wid >> 2, wc = wid & 3, fr = lane & 15, fq = lane >> 4;
    const int K = g.K, nt = K / BK;
    unsigned voffA[2], voffB[2];
#pragma unroll
    for (int i = 0; i < 2; ++i) { int R, C; stage_rc(tid * 16 + i * 8192, R, C); const int Rb = Epi::PERM ? ((R & ~31) + perm32(R & 31)) : R;
        voffA[i] = (unsigned)(R * K + C) * 2u; voffB[i] = (unsigned)(Rb * K + C) * 2u; }
    const size_t kstep = (size_t)(BK * 2);
    const size_t hstep = (size_t)HALF * K * 2;
    const size_t tstep = 2 * hstep;
    const unsigned ldsw = (unsigned)wid * 1024u;
    const int aoff = lds_byte(wr * 64 + fr, fq * 8), boff = lds_byte(wc * 32 + fr, fq * 8);
#define PG8_SA(b, h) (((b) * 2 + (h)) * HTB)
#define PG8_SB(b, h) ((4 + (b) * 2 + (h)) * HTB)
#define PG8_STAGE(bufoff, gbase, voff) do { _Pragma("unroll") for (int _i = 0; _i < 2; ++_i) \
        __builtin_amdgcn_global_load_lds((const unsigned*)((const char*)(gbase) + (voff)[_i]), (PG8_LAS unsigned*)(lds + (bufoff) + ldsw + _i * 8192), 16, 0, 0); } while (0)
#define PG8_LDA(dst, b, h) do { _Pragma("unroll") for (int m = 0; m < 4; ++m) _Pragma("unroll") for (int k = 0; k < 2; ++k) dst[m][k] = *(const PG8_LAS bf16x8*)(lds + PG8_SA(b, h) + aoff + m * 2048 + k * 1024); } while (0)
#define PG8_LDB(dst, b, h) do { _Pragma("unroll") for (int n = 0; n < 2; ++n) _Pragma("unroll") for (int k = 0; k < 2; ++k) dst[n][k] = *(const PG8_LAS bf16x8*)(lds + PG8_SB(b, h) + boff + n * 2048 + k * 1024); } while (0)
#define PG8_MMA(ai, bj, At, Bt) do { __builtin_amdgcn_s_setprio(1); _Pragma("unroll") for (int m = 0; m < 4; ++m) _Pragma("unroll") for (int n = 0; n < 2; ++n) _Pragma("unroll") for (int k = 0; k < 2; ++k) \
        acc[ai][bj][m][n] = __builtin_amdgcn_mfma_f32_16x16x32_bf16(Bt[n][k], At[m][k], acc[ai][bj][m][n], 0, 0, 0); __builtin_amdgcn_s_setprio(0); } while (0)
#define PG8_WAIT_V(n) asm volatile("s_waitcnt vmcnt(" #n ")" ::: "memory")
#define PG8_WAIT_L(n) asm volatile("s_waitcnt lgkmcnt(" #n ")" ::: "memory")
#define PG8_BAR __builtin_amdgcn_s_barrier()
#define PG8_SCHED __builtin_amdgcn_sched_barrier(0)
    Unit cur, nxt; int ui = 0;
    if (!S.next(0, cur)) return;
    f32x4 acc[2][2][4][2];
#pragma unroll
    for (int a = 0; a < 2; ++a)
#pragma unroll
        for (int b = 0; b < 2; ++b)
#pragma unroll
            for (int m = 0; m < 4; ++m)
#pragma unroll
                for (int n = 0; n < 2; ++n) acc[a][b][m][n] = (f32x4){0.f, 0.f, 0.f, 0.f};
    bf16x8 At[4][2], B0[2][2], B1[2][2];
    const char* cA = (const char*)g.A + (size_t)cur.pm * tstep; const char* cB = (const char*)g.Bt + (size_t)cur.pn * tstep;
    S.a_ready(cur);
    if constexpr (SP2) {
        PG8_STAGE(PG8_SB(0, 0), cB, voffB); PG8_STAGE(PG8_SB(0, 1), cB + hstep, voffB); PG8_STAGE(PG8_SA(0, 0), cA, voffA); PG8_STAGE(PG8_SA(0, 1), cA + hstep, voffA);
        if (wr == 1) PG8_BAR;
        PG8_WAIT_V(2); PG8_BAR;
        PG8_STAGE(PG8_SB(1, 0), cB + kstep, voffB); PG8_STAGE(PG8_SA(1, 0), cA + kstep, voffA); PG8_STAGE(PG8_SB(1, 1), cB + hstep + kstep, voffB);
        PG8_WAIT_V(6); PG8_BAR;
    } else {
        PG8_STAGE(PG8_SB(0, 0), cB, voffB); PG8_STAGE(PG8_SA(0, 0), cA, voffA); PG8_STAGE(PG8_SB(0, 1), cB + hstep, voffB); PG8_STAGE(PG8_SA(0, 1), cA + hstep, voffA);
        if (wr == 1) PG8_BAR;
        PG8_WAIT_V(4); PG8_BAR;
        PG8_STAGE(PG8_SB(1, 0), cB + kstep, voffB); PG8_STAGE(PG8_SA(1, 0), cA + kstep, voffA); PG8_STAGE(PG8_SB(1, 1), cB + hstep + kstep, voffB);
        PG8_WAIT_V(6); PG8_BAR;
    }
    for (;;) {
        const bool has_next = S.next(ui + 1, nxt);
        const char* nA = has_next ? (const char*)g.A + (size_t)nxt.pm * tstep : cA; const char* nB = has_next ? (const char*)g.Bt + (size_t)nxt.pn * tstep : cB;
        for (int t = 0; t < nt; t += 2) {
            const bool last = (t == nt - 2);
            const char* a1 = cA + (size_t)(t + 1) * kstep;
            const char* a2 = last ? nA : cA + (size_t)(t + 2) * kstep; const char* b2 = last ? nB : cB + (size_t)(t + 2) * kstep;
            const char* a3 = a2 + kstep; const char* b3 = b2 + kstep;
            if (last && has_next) S.a_ready(nxt);
            if constexpr (SP2) {
            PG8_LDB(B0, 0, 0); PG8_LDB(B1, 0, 1); PG8_SCHED; PG8_LDA(At, 0, 0); PG8_STAGE(PG8_SA(1, 1), a1 + hstep, voffA);
            PG8_WAIT_V(8); PG8_WAIT_L(0); PG8_BAR; PG8_MMA(0, 0, At, B0); PG8_MMA(0, 1, At, B1); PG8_BAR; PG8_SCHED;
            PG8_LDA(At, 0, 1); PG8_STAGE(PG8_SB(0, 0), b2, voffB); PG8_STAGE(PG8_SB(0, 1), b2 + hstep, voffB); PG8_STAGE(PG8_SA(0, 0), a2, voffA);
            PG8_WAIT_V(8); PG8_WAIT_L(0); PG8_BAR; PG8_MMA(1, 0, At, B0); PG8_MMA(1, 1, At, B1); PG8_BAR; PG8_SCHED;
            PG8_LDB(B0, 1, 0); PG8_LDB(B1, 1, 1); PG8_SCHED; PG8_LDA(At, 1, 0); PG8_STAGE(PG8_SA(0, 1), a2 + hstep, voffA);
            PG8_WAIT_V(8); PG8_WAIT_L(0); PG8_BAR; PG8_MMA(0, 0, At, B0); PG8_MMA(0, 1, At, B1); PG8_BAR; PG8_SCHED;
            PG8_LDA(At, 1, 1); PG8_STAGE(PG8_SB(1, 0), b3, voffB); PG8_STAGE(PG8_SB(1, 1), b3 + hstep, voffB); PG8_STAGE(PG8_SA(1, 0), a3, voffA);
            PG8_WAIT_V(8); PG8_WAIT_L(0); PG8_BAR; PG8_MMA(1, 0, At, B0); PG8_MMA(1, 1, At, B1); PG8_BAR; PG8_SCHED;
            } else {
            PG8_LDB(B0, 0, 0); PG8_SCHED; PG8_LDA(At, 0, 0); PG8_STAGE(PG8_SA(1, 1), a1 + hstep, voffA);
            PG8_WAIT_L(8); PG8_BAR; PG8_WAIT_L(0); PG8_MMA(0, 0, At, B0); PG8_BAR; PG8_SCHED;
            PG8_LDB(B1, 0, 1); PG8_STAGE(PG8_SB(0, 0), b2, voffB);
            PG8_BAR; PG8_WAIT_L(0); PG8_MMA(0, 1, At, B1); PG8_BAR;
            PG8_LDA(At, 0, 1); PG8_STAGE(PG8_SA(0, 0), a2, voffA);
            PG8_BAR; PG8_WAIT_L(0); PG8_MMA(1, 0, At, B0); PG8_BAR; PG8_SCHED;
            PG8_STAGE(PG8_SB(0, 1), b2 + hstep, voffB);
            PG8_WAIT_V(6); PG8_BAR; PG8_MMA(1, 1, At, B1); PG8_BAR;
            PG8_LDB(B0, 1, 0); PG8_SCHED; PG8_LDA(At, 1, 0); PG8_STAGE(PG8_SA(0, 1), a2 + hstep, voffA);
            PG8_WAIT_L(8); PG8_BAR; PG8_WAIT_L(0); PG8_MMA(0, 0, At, B0); PG8_BAR; PG8_SCHED;
            PG8_LDB(B1, 1, 1); PG8_STAGE(PG8_SB(1, 0), b3, voffB);
            PG8_BAR; PG8_WAIT_L(0); PG8_MMA(0, 1, At, B1); PG8_BAR;
            PG8_LDA(At, 1, 1); PG8_STAGE(PG8_SA(1, 0), a3, voffA);
            PG8_BAR; PG8_WAIT_L(0); PG8_MMA(1, 0, At, B0); PG8_BAR; PG8_SCHED;
            PG8_STAGE(PG8_SB(1, 1), b3 + hstep, voffB);
            PG8_WAIT_V(6); PG8_BAR; PG8_MMA(1, 1, At, B1); PG8_BAR;
            }
        }
        if constexpr (ALIGN_EPI) { if (wr == 0) PG8_BAR; }
        if constexpr (!Epi::AFTER_DRAIN) { E(acc, cur, wr, wc, fr, fq); S.done(cur); }
        if (!has_next) break;
#pragma unroll
        for (int a = 0; a < 2; ++a)
#pragma unroll
            for (int b = 0; b < 2; ++b)
#pragma unroll
                for (int m = 0; m < 4; ++m)
#pragma unroll
                    for (int n = 0; n < 2; ++n) acc[a][b][m][n] = (f32x4){0.f, 0.f, 0.f, 0.f};
        cur = nxt; cA = nA; cB = nB; ++ui;
        if constexpr (ALIGN_EPI) { if (wr == 1) PG8_BAR; }
    }
    PG8_WAIT_V(0);
    if constexpr (!ALIGN_EPI) { if (wr == 0) PG8_BAR; }
    PG8_BAR;
    if constexpr (Epi::AFTER_DRAIN) { E.fused(acc, cur, wr, wc, fr, fq, lds, wid, lane); S.done(cur); }
#undef PG8_SA
#undef PG8_SB
#undef PG8_STAGE
#undef PG8_LDA
#undef PG8_LDB
#undef PG8_MMA
#undef PG8_WAIT_V
#undef PG8_WAIT_L
#undef PG8_BAR
#undef PG8_SCHED
}
}
#define LAS __attribute__((address_space(3)))
#define XB_TMO      128
#define XB_XCNT(j)  (256  + 64 * (j))
#define XB_XSUB(j)  (1280 + 64 * (j))
#define XB_XGEN(j)  (2304 + 64 * (j))
#define XB_TOP      3328
#define XB_TOPGEN   3392
#define XCD_BAR_WORDS 3456
#define XB_SPIN_CAP (1u << 18)

__device__ __forceinline__ unsigned xb_ld(unsigned* p)              { return __hip_atomic_load(p, __ATOMIC_RELAXED, __HIP_MEMORY_SCOPE_AGENT); }
__device__ __forceinline__ unsigned xb_add(unsigned* p, unsigned v) { return __hip_atomic_fetch_add(p, v, __ATOMIC_RELAXED, __HIP_MEMORY_SCOPE_AGENT); }
__device__ __forceinline__ unsigned xb_xcc_id() { return (unsigned)__builtin_amdgcn_s_getreg((3 << 11) | 20) & 0xFu; }
#define XB_SPIN(cond, bar) do { unsigned _sp = 0; while (cond) { __builtin_amdgcn_s_sleep(1); \
    if ((++_sp & 255u) == 0u) { if (xb_ld(&(bar)[XB_TMO])) break; if (_sp > XB_SPIN_CAP) { atomicAdd(&(bar)[XB_TMO], 1u); break; } } } } while (0)

struct XcdBarrier {
    unsigned* bar; unsigned x;
    volatile LAS unsigned* st;
};

__device__ __forceinline__ XcdBarrier xcd_barrier_post(unsigned* bar, volatile LAS unsigned* st) {
    XcdBarrier b; b.bar = bar; b.x = xb_xcc_id(); b.st = st;
    if (threadIdx.x == 0) (void)xb_add(&bar[XB_XCNT(b.x)], 1u);
    return b;
}
__device__ __forceinline__ void xcd_barrier_complete(unsigned* bar, unsigned x, unsigned& nloc, unsigned& nx) {
    const unsigned G = gridDim.x * gridDim.y * gridDim.z;
    unsigned sum, cnt, mine, sp = 0u;
    for (;;) {
        sum = 0u; cnt = 0u; mine = 0u;
#pragma unroll
        for (unsigned j = 0; j < 16; ++j) { const unsigned c = xb_ld(&bar[XB_XCNT(j)]); sum += c; cnt += (c > 0u) ? 1u : 0u; mine = (j == x) ? c : mine; }
        if (sum == G) break;
        __builtin_amdgcn_s_sleep(1);
        if ((++sp & 255u) == 0u) { if (xb_ld(&bar[XB_TMO])) break; if (sp > XB_SPIN_CAP) { atomicAdd(&bar[XB_TMO], 1u); break; } }
    }
    nloc = mine > 0u ? mine : 1u; nx = cnt > 0u ? cnt : 1u;
}

__device__ __forceinline__ void xcd_barrier(const XcdBarrier& b) {
    asm volatile("s_waitcnt vmcnt(0)" ::: "memory");
    __syncthreads();
    if (threadIdx.x == 0) {
        unsigned* bar = b.bar;
        __builtin_amdgcn_s_waitcnt(0);
        unsigned nloc = b.st[0], nx = b.st[1];
        if (nloc == 0u) { xcd_barrier_complete(bar, b.x, nloc, nx); b.st[0] = nloc; b.st[1] = nx; }
        const unsigned old = xb_add(&bar[XB_XSUB(b.x)], 1u);
        const unsigned gen = old / nloc;
        if (old + 1u == (gen + 1u) * nloc) {
            __builtin_amdgcn_fence(__ATOMIC_RELEASE, "agent");
            asm volatile("s_waitcnt vmcnt(0)" ::: "memory");
            const unsigned og = xb_add(&bar[XB_TOP], 1u);
            const unsigned tg = og / nx;
            if (og + 1u == (tg + 1u) * nx) xb_add(&bar[XB_TOPGEN], 1u);
            else XB_SPIN(xb_ld(&bar[XB_TOPGEN]) == tg, bar);
            __builtin_amdgcn_fence(__ATOMIC_ACQUIRE, "agent");
            xb_add(&bar[XB_XGEN(b.x)], 1u);
            asm volatile("s_waitcnt vmcnt(0)" ::: "memory");
        } else {
            XB_SPIN(xb_ld(&bar[XB_XGEN(b.x)]) == gen, bar);
            __builtin_amdgcn_fence(__ATOMIC_ACQUIRE, "agent");
            asm volatile("s_waitcnt vmcnt(0)" ::: "memory");
        }
    }
    __syncthreads();
}
#undef LAS
namespace mk {
using pg8::bf16_t;
typedef float f32x4 __attribute__((ext_vector_type(4)));
typedef unsigned u32x4 __attribute__((ext_vector_type(4)));
typedef unsigned u32x2 __attribute__((ext_vector_type(2)));
constexpr int NWAVES = 8;
constexpr int D = 1024, SEQ = 2048, NBP = 8, NBS = 128, TS = 4, PAST = 2048;
constexpr int MP = NBP * SEQ, MS = NBS * TS, MT = MP + MS;
constexpr int GIN = 3088, NPROJ = 3072, FF = 2816, PLE = 256;
constexpr float EPS = 1e-6f;
constexpr size_t OUT_Y = 0, OUT_GSP = 17301504, OUT_GSS = 19398656, OUT_KP = 52953088, OUT_VP = 61341696, OUT_KS = 69730304, OUT_VS = 69992448;
constexpr size_t MiB = 1u << 20;
constexpr size_t al(size_t x) { return (x + 255) & ~(size_t)255; }
constexpr size_t WS_CTL = 0, CTL_BYTES = 2 * MiB;
constexpr int CW_BAR = 4096;
constexpr size_t WS_SSQ = 1 * MiB;
constexpr size_t WS_WIN = 2 * MiB;
constexpr size_t WS_WGLR = al(WS_WIN + 2ull * 3072 * 1024 * 2);
constexpr size_t WS_WAO = al(WS_WGLR + 2ull * 16 * 1024 * 4);
constexpr size_t WS_WQKV = al(WS_WAO + 2ull * 1024 * 1024 * 2);
constexpr size_t WS_WQ1 = al(WS_WQKV + 4096ull * 1024 * 2);
constexpr size_t WS_WBO = al(WS_WQ1 + 3072ull * 1024 * 2);
constexpr size_t WS_WFIN = al(WS_WBO + 2ull * 1024 * 1024 * 2);
constexpr size_t WS_WFOUT = al(WS_WFIN + 4ull * 5632 * 1024 * 2);
constexpr size_t WS_WPROJ = al(WS_WFOUT + 4ull * 1024 * 2816 * 2);
constexpr size_t WS_WGATE = al(WS_WPROJ + 4ull * 1024 * 256 * 2);
constexpr size_t WS_XB = al(WS_WGATE + 4ull * 1024 * 1024 * 2);
constexpr size_t WS_PROJ = al(WS_XB + 3ull * MT * 1024 * 2);
constexpr size_t WS_H = al(WS_PROJ + (size_t)MT * 3072 * 2);
constexpr size_t WS_ON = al(WS_H + (size_t)MT * 2816 * 2);
constexpr size_t WS_PP = al(WS_ON + (size_t)MT * 1024 * 2);
constexpr size_t WS_PB = al(WS_PP + 4ull * MT * 1024 * 2);
constexpr size_t WS_GLR = al(WS_PB + 4ull * MT * 256 * 2);
constexpr size_t WS_KVRAW = al(WS_GLR + (size_t)MT * 16 * 4);
constexpr size_t WS_KB = al(WS_KVRAW + (size_t)MT * 1024 * 4);
constexpr size_t WS_VB = al(WS_KB + (size_t)MT * 512 * 2);
constexpr size_t WS_VT = al(WS_VB + (size_t)MT * 512 * 2);
constexpr size_t WS_OG = al(WS_VT + 3ull * MP * 512 * 2);
constexpr size_t WS_LSE = al(WS_OG + 2ull * MP * 1024 * 2);
constexpr size_t WS_ROPE = al(WS_LSE + 2ull * MP * 8 * 4);
constexpr size_t WS_QIG = al(WS_ROPE + 2052ull * 16 * 2 * 4);
constexpr size_t WS_KETG = al(WS_QIG + (size_t)MP * 512 * 2);
constexpr size_t WS_VTG = al(WS_KETG + (size_t)MP * 512 * 2);
constexpr size_t WS_DECG = al(WS_VTG + (size_t)MP * 1024 * 2);
constexpr size_t WS_SSQM = al(WS_DECG + 1024ull * 128 * 4);
constexpr size_t WS_ATTG = al(WS_SSQM + 13ull * MP * 16 * 4);
constexpr size_t WS_CK = al(WS_ATTG + 1024ull * 64 * 64 * 2);
constexpr size_t WS_CV = al(WS_CK + 128ull * 4 * 900 * 128 * 2);
constexpr size_t WS_END = al(WS_CV + 128ull * 4 * 900 * 128 * 2);
constexpr int RING_BYTES = 139264, LDSCTL_OFF = RING_BYTES, MISC_OFF = LDSCTL_OFF + 320, LDS_BYTES = 147456;

#define LAS __attribute__((address_space(3)))
__device__ __forceinline__ float bf2f(bf16_t b) { return __uint_as_float(((unsigned)b) << 16); }
__device__ __forceinline__ float bflo(unsigned w) { return __uint_as_float(w << 16); }
__device__ __forceinline__ float bfhi(unsigned w) { return __uint_as_float(w & 0xffff0000u); }
__device__ __forceinline__ unsigned pk2(float lo, float hi) { return pg8::cvt_pk_bf16(lo, hi); }
__device__ __forceinline__ float wave_sum(float v) {
#pragma unroll
    for (int o = 1; o < 64; o <<= 1) v += __shfl_xor(v, o);
    return v;
}
__device__ __forceinline__ float wave_max(float v) {
#pragma unroll
    for (int o = 1; o < 64; o <<= 1) v = fmaxf(v, __shfl_xor(v, o));
    return v;
}
#define LDS_WAIT() asm volatile("s_waitcnt lgkmcnt(0)" ::: "memory")
#define LDS_BARRIER() do { asm volatile("s_waitcnt lgkmcnt(0)" ::: "memory"); __builtin_amdgcn_s_barrier(); asm volatile("" ::: "memory"); } while (0)

struct Args { const float* in[26]; float* out; unsigned char* ws; int ph_lo, ph_hi, use_bar, pad; };

struct Frame {
    LAS unsigned char* lds; int tid, lane, wave, vcu, G;
};

struct MatDesc { const float* W; int ldw, K, Nd, kind; bf16_t* WT; const float* gain; };
__device__ __forceinline__ void get_mat(const Args& A, int mi, MatDesc& m) {
    unsigned char* ws = A.ws;
    if (mi < 2) { const int l = mi; m = MatDesc{A.in[8] + (size_t)l * 1024 * GIN, GIN, 1024, 3072, 1, (bf16_t*)(ws + WS_WIN) + (size_t)l * 3072 * 1024, A.in[7] + l * 1024}; return; }
    if (mi < 4) { const int l = mi - 2; m = MatDesc{A.in[12] + (size_t)l * 1024 * 1024, 1024, 1024, 1024, 0, (bf16_t*)(ws + WS_WAO) + (size_t)l * 1024 * 1024, nullptr}; return; }
    if (mi == 4) { m = MatDesc{A.in[17], 3072, 1024, 3072, 0, (bf16_t*)(ws + WS_WQKV), A.in[16]}; return; }
    if (mi == 5) { m = MatDesc{A.in[14], 1024, 1024, 1024, 0, (bf16_t*)(ws + WS_WQKV) + (size_t)3072 * 1024, A.in[13]}; return; }
    if (mi == 6) { m = MatDesc{A.in[17] + (size_t)1024 * 3072, 3072, 1024, 3072, 0, (bf16_t*)(ws + WS_WQ1), A.in[16] + 1024}; return; }
    if (mi < 9) { const int j = mi - 7; m = MatDesc{A.in[19] + (size_t)j * 1024 * 1024, 1024, 1024, 1024, 0, (bf16_t*)(ws + WS_WBO) + (size_t)j * 1024 * 1024, nullptr}; return; }
    if (mi < 13) { const int i = mi - 9; m = MatDesc{A.in[21] + (size_t)i * 1024 * 5632, 5632, 1024, 5632, 2, (bf16_t*)(ws + WS_WFIN) + (size_t)i * 5632 * 1024, A.in[20] + i * 1024}; return; }
    if (mi < 17) { const int i = mi - 13; m = MatDesc{A.in[22] + (size_t)i * 2816 * 1024, 1024, 2816, 1024, 0, (bf16_t*)(ws + WS_WFOUT) + (size_t)i * 1024 * 2816, nullptr}; return; }
    if (mi < 21) { const int i = mi - 17; m = MatDesc{A.in[24] + (size_t)i * 256 * 1024, 1024, 256, 1024, 0, (bf16_t*)(ws + WS_WPROJ) + (size_t)i * 1024 * 256, nullptr}; return; }
    { const int i = mi - 21; m = MatDesc{A.in[25] + (size_t)i * 1024 * 1024, 1024, 1024, 1024, 0, (bf16_t*)(ws + WS_WGATE) + (size_t)i * 1024 * 1024, A.in[23] + i * 1024}; }
}
constexpr int NMAT = 25;
__device__ __forceinline__ void transpose_item(const MatDesc& m, int item, LAS float* scr, int lane) {
    const int nblk = m.Nd >> 6, kb = item / nblk, nb = item - kb * nblk, k0 = 64 * kb, n0 = 64 * nb;
    int src0 = n0; float scale = 1.0f;
    if (m.kind == 1) { if (n0 < 512) scale = 0.08838834764831845f; }
    if (m.kind == 2) { const int pn = n0 >> 8, half = (n0 >> 7) & 1, i0 = n0 & 127; src0 = half * FF + 128 * pn + i0; }
    const int kq = lane >> 4, n4 = lane & 15;
    f32x4 v[16]; float g[16];
#pragma unroll
    for (int i = 0; i < 16; ++i) { v[i] = __builtin_nontemporal_load((const f32x4*)(m.W + (size_t)(k0 + 4 * i + kq) * m.ldw + src0 + 4 * n4)); g[i] = m.gain ? m.gain[k0 + 4 * i + kq] * scale : scale; }
#pragma unroll
    for (int i = 0; i < 16; ++i) { LAS float* d = scr + (4 * i + kq) * 65 + 4 * n4; d[0] = v[i][0] * g[i]; d[1] = v[i][1] * g[i]; d[2] = v[i][2] * g[i]; d[3] = v[i][3] * g[i]; }
    LDS_WAIT();
    const int c = lane & 7;
#pragma unroll
    for (int j = 0; j < 8; ++j) { const int n = (lane >> 3) + 8 * j; const LAS float* sp = scr + (8 * c) * 65 + n;
        u32x4 o; o.x = pk2(sp[0 * 65], sp[1 * 65]); o.y = pk2(sp[2 * 65], sp[3 * 65]); o.z = pk2(sp[4 * 65], sp[5 * 65]); o.w = pk2(sp[6 * 65], sp[7 * 65]);
        *(u32x4*)(m.WT + (size_t)(n0 + n) * m.K + k0 + 8 * c) = o; }
    LDS_WAIT();
}
__device__ __forceinline__ void p0_prologue(const Args& A, Frame& F) {
    LAS float* scr = (LAS float*)(F.lds + F.wave * 17408);
    const int gw = F.vcu * NWAVES + F.wave, NGW = F.G * NWAVES, lane = F.lane;
    {
        int base = 0;
        for (int mi = 0; mi < NMAT; ++mi) {
            MatDesc m; get_mat(A, mi, m);
            const int cnt = (m.K >> 6) * (m.Nd >> 6);
            int it = gw - (base % NGW); if (it < 0) it += NGW;
            for (; it < cnt; it += NGW) transpose_item(m, it, scr, lane);
            base += cnt;
        }
    }
    {
        bf16_t* wg = (bf16_t*)(A.ws + WS_WGLR);
        for (int e = (gw * 64 + lane); e < 2 * 16 * 1024; e += NGW * 64) { const int l = e >> 14, j = (e >> 10) & 15, k = e & 1023;
            wg[e] = (bf16_t)(pk2(A.in[7][l * 1024 + k] * A.in[8][((size_t)l * 1024 + k) * GIN + 3072 + j], 0.f) & 0xffffu); }
    }
    {
        float* rt = (float*)(A.ws + WS_ROPE);
        for (int e = gw * 64 + lane; e < 2052 * 16; e += NGW * 64) { const int pos = e >> 4, i = e & 15; float sn, cs; sincosf((float)pos * powf(500000.0f, -(float)i * (1.0f / 16.0f)), &sn, &cs);
            rt[2 * e] = cs; rt[2 * e + 1] = sn; }
    }
    {
        bf16_t* xb = (bf16_t*)(A.ws + WS_XB); float* ssq = (float*)(A.ws + WS_SSQ);
        for (int r0 = 2 * gw; r0 < MT; r0 += 2 * NGW) {
            f32x4 v[2][4];
#pragma unroll
            for (int q = 0; q < 2; ++q) { const int r = r0 + q; const float* src = r < MP ? A.in[0] + (size_t)r * D : A.in[1] + (size_t)(r - MP) * D;
#pragma unroll
                for (int j = 0; j < 4; ++j) v[q][j] = __builtin_nontemporal_load((const f32x4*)(src + 256 * j + 4 * lane)); }
#pragma unroll
            for (int q = 0; q < 2; ++q) { const int r = r0 + q; float ss = 0.f;
#pragma unroll
                for (int j = 0; j < 4; ++j) { const f32x4 w4 = v[q][j];
                    u32x2 w; w.x = pk2(w4[0], w4[1]); w.y = pk2(w4[2], w4[3]); *(u32x2*)(xb + (size_t)r * D + 256 * j + 4 * lane) = w;
                    ss += (w4[0] * w4[0] + w4[1] * w4[1]) + (w4[2] * w4[2] + w4[3] * w4[3]); }
                ss = wave_sum(ss); float* sp = r < MP ? (float*)(A.ws + WS_SSQM) + (size_t)r * 16 : ssq + (size_t)(r - MP) * 16; if (lane < 16) sp[lane] = lane == 0 ? ss : 0.f; }
        }
    }
    {
        bf16_t* pb = (bf16_t*)(A.ws + WS_PB);
        for (int e0 = 11 * gw; e0 < 4 * MT; e0 += 11 * NGW) {
            f32x4 v[11];
#pragma unroll
            for (int q = 0; q < 11; ++q) { const int e = e0 + q, l = e / MT, r = e - l * MT;
                const float* src = r < MP ? A.in[2] + ((size_t)l * MP + r) * PLE : A.in[3] + ((size_t)l * MS + (r - MP)) * PLE; v[q] = __builtin_nontemporal_load((const f32x4*)(src + 4 * lane)); }
#pragma unroll
            for (int q = 0; q < 11; ++q) { const int e = e0 + q, l = e / MT, r = e - l * MT; u32x2 w; w.x = pk2(v[q][0], v[q][1]); w.y = pk2(v[q][2], v[q][3]);
                *(u32x2*)(pb + ((size_t)l * MT + r) * PLE + 4 * lane) = w; }
        }
    }
}

__device__ __forceinline__ void glr_rows(const Args& A, Frame& F, int l, const bf16_t* xb, const float* ssq, const float* ssqs) {
    typedef short gbf16x8 __attribute__((ext_vector_type(8)));
    const int gw = F.vcu * NWAVES + F.wave, NGW = F.G * NWAVES, lane = F.lane, i16 = lane & 15, q = lane >> 4;
    const bf16_t* wg = (const bf16_t*)(A.ws + WS_WGLR) + (size_t)l * 16 * 1024 + (size_t)i16 * 1024 + 8 * q;
    float* glr = (float*)(A.ws + WS_GLR);
    for (int tile = gw; tile < MT / 16; tile += NGW) {
        const int row0 = 16 * tile; const bf16_t* ap = xb + (size_t)(row0 + i16) * D + 8 * q;
        f32x4 acc = (f32x4){0.f, 0.f, 0.f, 0.f};
#pragma unroll
        for (int h2 = 0; h2 < 2; ++h2) {
            gbf16x8 a[16], b[16];
#pragma unroll
            for (int ks = 0; ks < 16; ++ks) { a[ks] = *(const gbf16x8*)(ap + 32 * (16 * h2 + ks)); b[ks] = *(const gbf16x8*)(wg + 32 * (16 * h2 + ks)); }
#pragma unroll
            for (int ks = 0; ks < 16; ++ks) acc = __builtin_amdgcn_mfma_f32_16x16x32_bf16(a[ks], b[ks], acc, 0, 0, 0);
        }
#pragma unroll
        for (int rg = 0; rg < 4; ++rg) { const int row = row0 + 4 * q + rg; glr[(size_t)row * 16 + i16] = acc[rg] * (row < MP ? pg8::rstd_of(ssq, row) : pg8::rstd_of(ssqs, row - MP)); }
    }
}

__device__ __forceinline__ void gla_naive_item(const Args& A, Frame& F, int l, int item) {
    const bool samp = item < 512; const int idx = samp ? item : item - 512; const int b = idx >> 2, h = idx & 3;
    const int row0 = samp ? MP + TS * b : b * SEQ; const int T = samp ? TS : SEQ;
    const int tid = F.tid, dv = tid & 255, half = tid >> 8, lane = F.lane;
    LAS float* aL = (LAS float*)(F.lds); LAS float* kL = aL + 1024; LAS float* qL = kL + 1024; LAS float* oL = qL + 1024;
    const bf16_t* proj = (const bf16_t*)(A.ws + WS_PROJ); const float* glr = (const float*)(A.ws + WS_GLR);
    const float* wup = A.in[9] + (size_t)l * 16 * 512 + h * 128; const float* bgk = A.in[10] + l * 512 + h * 128; const float* onorm = A.in[11] + l * 256;
    bf16_t* on = (bf16_t*)(A.ws + WS_ON);
    float S[64];
    if (samp) { const float* s0 = A.in[4] + ((((size_t)l * NBS + b) * 4 + h) * 128 + 64 * half) * 256 + dv;
#pragma unroll
        for (int i = 0; i < 64; ++i) S[i] = __builtin_nontemporal_load(s0 + (size_t)i * 256); }
    else {
#pragma unroll
        for (int i = 0; i < 64; ++i) S[i] = 0.f; }
    for (int t0 = 0; t0 < T; t0 += 8) {
        const int tb = (T - t0) < 8 ? (T - t0) : 8;
        for (int e = tid; e < tb * 128; e += 512) { const int tt = e >> 7, dk = e & 127; const size_t row = (size_t)(row0 + t0 + tt);
            float z = bgk[dk];
#pragma unroll
            for (int j = 0; j < 16; ++j) z += glr[row * 16 + j] * wup[j * 512 + dk];
            const float ls = fminf(z, 0.f) - log1pf(expf(-fabsf(z)));
            aL[e] = expf(ls * (1.0f / 16.0f));
            kL[e] = bf2f(proj[row * NPROJ + 512 + h * 128 + dk]); qL[e] = bf2f(proj[row * NPROJ + h * 128 + dk]); }
        __syncthreads();
        float vv[8];
#pragma unroll
        for (int tt = 0; tt < 8; ++tt) vv[tt] = tt < tb ? bf2f(proj[(size_t)(row0 + t0 + tt) * NPROJ + 1024 + h * 256 + dv]) : 0.f;
#pragma unroll
        for (int tt = 0; tt < 8; ++tt) {
            if (tt < tb) { const LAS float* a = aL + tt * 128 + 64 * half; const LAS float* k = kL + tt * 128 + 64 * half; const LAS float* q = qL + tt * 128 + 64 * half; float o = 0.f; const float v = vv[tt];
#pragma unroll
                for (int i = 0; i < 64; ++i) { S[i] = a[i] * S[i] + k[i] * v; o += q[i] * S[i]; }
                oL[(half * 8 + tt) * 256 + dv] = o; }
        }
        __syncthreads();
        { const int tt = F.wave;
          if (tt < tb) { const size_t row = (size_t)(row0 + t0 + tt);
              const f32x4 o0 = *(const LAS f32x4*)(oL + (0 * 8 + tt) * 256 + 4 * lane), o1 = *(const LAS f32x4*)(oL + (1 * 8 + tt) * 256 + 4 * lane); const f32x4 o = o0 + o1;
              const float ss = wave_sum((o[0] * o[0] + o[1] * o[1]) + (o[2] * o[2] + o[3] * o[3])); const float rs = __builtin_amdgcn_rsqf(ss * (1.0f / 256.0f) + EPS);
              const u32x2 rw = *(const u32x2*)(proj + row * NPROJ + 2048 + h * 256 + 4 * lane); const f32x4 g = *(const f32x4*)(onorm + 4 * lane);
              const float r0 = bflo(rw.x), r1 = bfhi(rw.x), r2 = bflo(rw.y), r3 = bfhi(rw.y);
              u32x2 w; w.x = pk2(o[0] * rs * g[0] * r0 * pg8::fast_sigmoid(r0), o[1] * rs * g[1] * r1 * pg8::fast_sigmoid(r1));
              w.y = pk2(o[2] * rs * g[2] * r2 * pg8::fast_sigmoid(r2), o[3] * rs * g[3] * r3 * pg8::fast_sigmoid(r3));
              *(u32x2*)(on + row * D + h * 256 + 4 * lane) = w; } }
        __syncthreads();
    }
    float* so = (samp ? A.out + OUT_GSS + (((size_t)l * NBS + b) * 4 + h) * 128 * 256 : A.out + OUT_GSP + (((size_t)l * NBP + b) * 4 + h) * 128 * 256) + (size_t)(64 * half) * 256 + dv;
#pragma unroll
    for (int i = 0; i < 64; ++i) __builtin_nontemporal_store(S[i], so + (size_t)i * 256);
}

__device__ __forceinline__ float rope_freq(int i) { return powf(500000.0f, -(float)i * (1.0f / 16.0f)); }
__device__ __forceinline__ void kn_rows(const Args& A, Frame& F) {
    const int gw = F.vcu * NWAVES + F.wave, NGW = F.G * NWAVES, lane = F.lane;
    const float* kv = (const float*)(A.ws + WS_KVRAW); bf16_t* kb = (bf16_t*)(A.ws + WS_KB); bf16_t* vb = (bf16_t*)(A.ws + WS_VB);
    const float* kn = A.in[15];
    const int d0 = (lane & 15) * 8;
    for (int r = gw; r < MT; r += NGW) {
        const bool samp = r >= MP; const int ipos = samp ? (PAST + ((r - MP) & 3)) : (r & (SEQ - 1));
        float* ko = samp ? A.out + OUT_KS + (size_t)(r - MP) * 512 : A.out + OUT_KP + (size_t)r * 512;
        float* vo = samp ? A.out + OUT_VS + (size_t)(r - MP) * 512 : A.out + OUT_VP + (size_t)r * 512;
        const f32x4 k0 = *(const f32x4*)(kv + (size_t)r * 1024 + 8 * lane), k1 = *(const f32x4*)(kv + (size_t)r * 1024 + 8 * lane + 4);
        const f32x4 v0 = *(const f32x4*)(kv + (size_t)r * 1024 + 512 + 8 * lane), v1 = *(const f32x4*)(kv + (size_t)r * 1024 + 512 + 8 * lane + 4);
        float x[8] = {k0[0], k0[1], k0[2], k0[3], k1[0], k1[1], k1[2], k1[3]};
        float ss = 0.f;
#pragma unroll
        for (int j = 0; j < 8; ++j) ss += x[j] * x[j];
        ss += __shfl_xor(ss, 1); ss += __shfl_xor(ss, 2); ss += __shfl_xor(ss, 4); ss += __shfl_xor(ss, 8);
        const float rs = __builtin_amdgcn_rsqf(ss * (1.0f / 128.0f) + EPS);
#pragma unroll
        for (int j = 0; j < 8; ++j) x[j] = x[j] * rs * kn[d0 + j];
        float y[8];
#pragma unroll
        for (int j = 0; j < 8; ++j) y[j] = __shfl_xor(x[j], 2);
        const int lq = lane & 15;
        if (lq < 4) {
#pragma unroll
            for (int j = 0; j < 8; ++j) { const int fi = (d0 + j) & 15; const float* rt = (const float*)(A.ws + WS_ROPE) + ((size_t)ipos * 16 + fi) * 2; const float cs = rt[0], sn = rt[1];
                x[j] = (lq < 2) ? (x[j] * cs - y[j] * sn) : (x[j] * cs + y[j] * sn); }
        }
        __builtin_nontemporal_store((f32x4){x[0], x[1], x[2], x[3]}, (f32x4*)(ko + 8 * lane)); __builtin_nontemporal_store((f32x4){x[4], x[5], x[6], x[7]}, (f32x4*)(ko + 8 * lane + 4));
        __builtin_nontemporal_store(v0, (f32x4*)(vo + 8 * lane)); __builtin_nontemporal_store(v1, (f32x4*)(vo + 8 * lane + 4));
        u32x4 kw; kw.x = pk2(x[0], x[1]); kw.y = pk2(x[2], x[3]); kw.z = pk2(x[4], x[5]); kw.w = pk2(x[6], x[7]); *(u32x4*)(kb + (size_t)r * 512 + 8 * lane) = kw;
        u32x4 vw; vw.x = pk2(v0[0], v0[1]); vw.y = pk2(v0[2], v0[3]); vw.z = pk2(v1[0], v1[1]); vw.w = pk2(v1[2], v1[3]); *(u32x4*)(vb + (size_t)r * 512 + 8 * lane) = vw;
        if (samp) { const int bs = (r - MP) >> 2, ts = (r - MP) & 3; const size_t o = (((size_t)bs * 4 + (lane >> 4)) * 900 + 896 + ts) * 128 + d0;
            *(u32x4*)((bf16_t*)(A.ws + WS_CK) + o) = kw; *(u32x4*)((bf16_t*)(A.ws + WS_CV) + o) = vw; }
    }
}


__device__ __forceinline__ void cache_compact(const Args& A, Frame& F, int which, int w0, int nw) {
    const int lane = F.lane; const float* src = which ? A.in[6] : A.in[5]; bf16_t* dst = (bf16_t*)(A.ws + (which ? WS_CV : WS_CK));
    const int kvh = lane >> 4, d0 = (lane & 15) * 8;
#pragma unroll 4
    for (int e = w0; e < NBS * 896; e += nw) { const int b = e / 896, slot = e - b * 896;
        const int idx = slot < 512 ? 1536 + slot : (((slot - 512) >> 2) << 4) + ((slot - 512) & 3);
        const float* p = src + (((size_t)b * PAST + idx) * 4 + kvh) * 128 + d0;
        const f32x4 a = __builtin_nontemporal_load((const f32x4*)p), c = __builtin_nontemporal_load((const f32x4*)(p + 4));
        u32x4 w; w.x = pk2(a[0], a[1]); w.y = pk2(a[2], a[3]); w.z = pk2(c[0], c[1]); w.w = pk2(c[2], c[3]);
        *(u32x4*)(dst + (((size_t)b * 4 + kvh) * 900 + slot) * 128 + d0) = w; }
}
typedef short bf16x8 __attribute__((ext_vector_type(8)));
typedef float f32x16 __attribute__((ext_vector_type(16)));
constexpr int ATT_KS = 0, ATT_KSTR = 272, ATT_VS = 69632, ATT_VSTR = 528;
__device__ __forceinline__ unsigned pkc(float a, float b) { __hip_bfloat162 v = __float22bfloat162_rn(make_float2(a, b)); unsigned u; __builtin_memcpy(&u, &v, 4); return u; }
__device__ __forceinline__ bf16x8 pack8(float a0, float a1, float a2, float a3, float a4, float a5, float a6, float a7) {
    u32x4 p; p.x = pkc(a0, a1); p.y = pkc(a2, a3); p.z = pkc(a4, a5); p.w = pkc(a6, a7); return __builtin_bit_cast(bf16x8, p); }
#define MFMA32(a, b, c) __builtin_amdgcn_mfma_f32_32x32x16_bf16((a), (b), (c), 0, 0, 0)

template <bool LAST> __device__ __forceinline__ void att_unit(const Args& A, Frame& F, int j, int un) {
    const int lane = F.lane, r = lane & 31, h = lane >> 5, wv = F.wave, hq = wv >> 2, sb = wv & 3, tid = F.tid;
    const int g = un >> 9, rem = un & 511, bk = rem >> 4, w16 = rem & 15, b = bk >> 2, kvh = bk & 3;
    const int dsh = 2 * g, dil = 1 << dsh, nblk = 16 >> dsh, c = w16 / nblk, jb = w16 - c * nblk;
    const int kb_lo = jb == 0 ? 128 : 0;
    const bf16_t* kbp = (const bf16_t*)(A.ws + WS_KB);
    const bf16_t* vt = (const bf16_t*)(A.ws + WS_VT) + (size_t)g * ((size_t)MP * 512);
    const int ulen = SEQ >> dsh;
    {
        u32x4 kreg[8], vreg[8];
#pragma unroll
        for (int i = 0; i < 8; ++i) { const int e = tid + 512 * i, row = e >> 4, pc = e & 15;
            if (row >= kb_lo) { const int u = jb * 128 - 128 + row, pos = (u << dsh) + c; kreg[i] = *(const u32x4*)(kbp + ((size_t)(b * SEQ + pos)) * 512 + kvh * 128 + pc * 8); } }
#pragma unroll
        for (int i = 0; i < 8; ++i) { const int e = tid + 512 * i, d = e >> 5, pc = e & 31;
            if (pc * 8 >= kb_lo) vreg[i] = *(const u32x4*)(vt + ((size_t)((bk * dil + c) * 128 + d)) * ulen + (jb * 128 - 128) + pc * 8); }
#pragma unroll
        for (int i = 0; i < 8; ++i) { const int e = tid + 512 * i, row = e >> 4, pc = e & 15;
            if (row >= kb_lo) *(LAS u32x4*)(F.lds + ATT_KS + row * ATT_KSTR + pc * 16) = kreg[i]; }
#pragma unroll
        for (int i = 0; i < 8; ++i) { const int e = tid + 512 * i, d = e >> 5, pc = e & 31;
            if (pc * 8 >= kb_lo) *(LAS u32x4*)(F.lds + ATT_VS + d * ATT_VSTR + pc * 16) = vreg[i]; }
    }
    const int qi = jb * 128 + 32 * sb + r, qpos = (qi << dsh) + c; const size_t qrow = (size_t)(b * SEQ + qpos);
    const int slot = kvh * 2 + hq;
    bf16x8 qf[8];
    {
        const bf16_t* qsrc = (const bf16_t*)(A.ws + WS_PROJ) + qrow * NPROJ + g * 1024 + slot * 128 + 8 * h;
        const float* qn = A.in[18] + j * 128 + 8 * h;
        u32x4 qraw[8];
#pragma unroll
        for (int s = 0; s < 8; ++s) qraw[s] = *(const u32x4*)(qsrc + 16 * s);
        float ss = 0.f;
#pragma unroll
        for (int s = 0; s < 8; ++s) { const u32x4 w = qraw[s]; ss += (bflo(w.x) * bflo(w.x) + bfhi(w.x) * bfhi(w.x)) + (bflo(w.y) * bflo(w.y) + bfhi(w.y) * bfhi(w.y)) + (bflo(w.z) * bflo(w.z) + bfhi(w.z) * bfhi(w.z)) + (bflo(w.w) * bflo(w.w) + bfhi(w.w) * bfhi(w.w)); }
        ss += __shfl_xor(ss, 32);
        const float rs = (__builtin_amdgcn_rsqf(ss * (1.0f / 128.0f) + EPS)) * (0.08838834764831845f * 1.4426950408889634f);
        float x1[8], x2[8];
        { const u32x4 w0 = qraw[0], w1 = qraw[1]; const f32x4 ga = *(const f32x4*)(qn), gb = *(const f32x4*)(qn + 4), gc = *(const f32x4*)(qn + 16), gd = *(const f32x4*)(qn + 20);
          x1[0] = bflo(w0.x) * ga[0]; x1[1] = bfhi(w0.x) * ga[1]; x1[2] = bflo(w0.y) * ga[2]; x1[3] = bfhi(w0.y) * ga[3]; x1[4] = bflo(w0.z) * gb[0]; x1[5] = bfhi(w0.z) * gb[1]; x1[6] = bflo(w0.w) * gb[2]; x1[7] = bfhi(w0.w) * gb[3];
          x2[0] = bflo(w1.x) * gc[0]; x2[1] = bfhi(w1.x) * gc[1]; x2[2] = bflo(w1.y) * gc[2]; x2[3] = bfhi(w1.y) * gc[3]; x2[4] = bflo(w1.z) * gd[0]; x2[5] = bfhi(w1.z) * gd[1]; x2[6] = bflo(w1.w) * gd[2]; x2[7] = bfhi(w1.w) * gd[3]; }
        const float* rp = (const float*)(A.ws + WS_ROPE) + ((size_t)qpos * 16 + 8 * h) * 2;
        float y1[8], y2[8];
#pragma unroll
        for (int q4 = 0; q4 < 4; ++q4) { const f32x4 cs = *(const f32x4*)(rp + 4 * q4);
            y1[2 * q4] = (x1[2 * q4] * cs[0] - x2[2 * q4] * cs[1]) * rs; y2[2 * q4] = (x2[2 * q4] * cs[0] + x1[2 * q4] * cs[1]) * rs;
            y1[2 * q4 + 1] = (x1[2 * q4 + 1] * cs[2] - x2[2 * q4 + 1] * cs[3]) * rs; y2[2 * q4 + 1] = (x2[2 * q4 + 1] * cs[2] + x1[2 * q4 + 1] * cs[3]) * rs; }
        qf[0] = pack8(y1[0], y1[1], y1[2], y1[3], y1[4], y1[5], y1[6], y1[7]);
        qf[1] = pack8(y2[0], y2[1], y2[2], y2[3], y2[4], y2[5], y2[6], y2[7]);
#pragma unroll
        for (int s = 2; s < 8; ++s) { const u32x4 w = qraw[s]; const f32x4 ga = *(const f32x4*)(qn + 16 * s), gb = *(const f32x4*)(qn + 16 * s + 4);
            qf[s] = pack8(bflo(w.x) * ga[0] * rs, bfhi(w.x) * ga[1] * rs, bflo(w.y) * ga[2] * rs, bfhi(w.y) * ga[3] * rs, bflo(w.z) * gb[0] * rs, bfhi(w.z) * gb[1] * rs, bflo(w.w) * gb[2] * rs, bfhi(w.w) * gb[3] * rs); }
    }
    LDS_BARRIER();
    const int kt_lo = (jb == 0) ? (4 - sb) : 0;
    f32x16 S[5];
#pragma unroll
    for (int kt = 0; kt < 5; ++kt) {
#pragma unroll
        for (int i = 0; i < 16; ++i) S[kt][i] = 0.f;
        if (kt >= kt_lo) { const LAS unsigned char* kp = F.lds + ATT_KS + (32 * (sb + kt) + r) * ATT_KSTR + 16 * h;
#pragma unroll
            for (int s = 0; s < 8; ++s) { const bf16x8 kf = *(const LAS bf16x8*)(kp + 32 * s); S[kt] = MFMA32(kf, qf[s], S[kt]); } }
    }
#pragma unroll
    for (int i = 0; i < 16; ++i) { const int kk = (i & 3) + 8 * (i >> 2) + 4 * h; if (kk < r) S[0][i] = -1e30f; if (kk > r) S[4][i] = -1e30f; }
    float mx = -1e30f;
#pragma unroll
    for (int kt = 0; kt < 5; ++kt) { if (kt >= kt_lo) {
#pragma unroll
        for (int i = 0; i < 16; ++i) mx = fmaxf(mx, S[kt][i]); } }
    mx = fmaxf(mx, __shfl_xor(mx, 32));
    float l = 0.f;
#pragma unroll
    for (int kt = 0; kt < 5; ++kt) { if (kt >= kt_lo) {
#pragma unroll
        for (int i = 0; i < 16; ++i) { const float p = __builtin_amdgcn_exp2f(S[kt][i] - mx); S[kt][i] = p; l += p; } } }
    l += __shfl_xor(l, 32);
    f32x16 o[4];
#pragma unroll
    for (int dt = 0; dt < 4; ++dt)
#pragma unroll
        for (int i = 0; i < 16; ++i) o[dt][i] = 0.f;
#pragma unroll
    for (int kt = 0; kt < 5; ++kt) {
        if (kt >= kt_lo) {
#pragma unroll
            for (int s2 = 0; s2 < 2; ++s2) {
                const bf16x8 pf = pack8(S[kt][8 * s2], S[kt][8 * s2 + 1], S[kt][8 * s2 + 2], S[kt][8 * s2 + 3], S[kt][8 * s2 + 4], S[kt][8 * s2 + 5], S[kt][8 * s2 + 6], S[kt][8 * s2 + 7]);
                const LAS unsigned char* vp = F.lds + ATT_VS + r * ATT_VSTR + (32 * (sb + kt) + 16 * s2 + 4 * h) * 2;
#pragma unroll
                for (int dt = 0; dt < 4; ++dt) { const u32x2 lo = *(const LAS u32x2*)(vp + dt * 32 * ATT_VSTR), hi = *(const LAS u32x2*)(vp + dt * 32 * ATT_VSTR + 16);
                    u32x4 vv; vv.x = lo.x; vv.y = lo.y; vv.z = hi.x; vv.w = hi.y;
                    o[dt] = MFMA32(__builtin_bit_cast(bf16x8, vv), pf, o[dt]); }
            }
        }
    }
    const float inv = __builtin_amdgcn_rcpf(l), lse = (mx + __log2f(l)) * 0.6931471805599453f;
    bf16_t* og = (bf16_t*)(A.ws + WS_OG);
    float* lsep = (float*)(A.ws + WS_LSE);
    if (!LAST) {
        const int gs = g ? 1 : 0;
        bf16_t* dst = og + ((size_t)gs * MP + qrow) * 1024 + slot * 128 + 4 * h;
#pragma unroll
        for (int dt = 0; dt < 4; ++dt)
#pragma unroll
            for (int i4 = 0; i4 < 4; ++i4) { u32x2 w; w.x = pkc(o[dt][4 * i4] * inv, o[dt][4 * i4 + 1] * inv); w.y = pkc(o[dt][4 * i4 + 2] * inv, o[dt][4 * i4 + 3] * inv);
                *(u32x2*)(dst + 32 * dt + 8 * i4) = w; }
        if (h == 0) lsep[((size_t)gs * MP + qrow) * 8 + slot] = lse;
    } else {
        const float l0 = lsep[((size_t)0 * MP + qrow) * 8 + slot], l1 = lsep[((size_t)1 * MP + qrow) * 8 + slot];
        const float ml = fmaxf(fmaxf(l0, l1), lse); const float w0 = __expf(l0 - ml), w1 = __expf(l1 - ml), w2 = __expf(lse - ml); const float wi = __builtin_amdgcn_rcpf(w0 + w1 + w2);
        const float c0 = w0 * wi, c1 = w1 * wi, c2 = w2 * wi * inv;
        const bf16_t* s0 = og + ((size_t)0 * MP + qrow) * 1024 + slot * 128 + 4 * h; const bf16_t* s1 = og + ((size_t)1 * MP + qrow) * 1024 + slot * 128 + 4 * h;
        bf16_t* dst = (bf16_t*)(A.ws + WS_ON) + qrow * 1024 + slot * 128 + 4 * h;
#pragma unroll
        for (int dt = 0; dt < 4; ++dt)
#pragma unroll
            for (int i4 = 0; i4 < 4; ++i4) { const u32x2 a = *(const u32x2*)(s0 + 32 * dt + 8 * i4), bb = *(const u32x2*)(s1 + 32 * dt + 8 * i4);
                u32x2 w; w.x = pkc(c0 * bflo(a.x) + c1 * bflo(bb.x) + c2 * o[dt][4 * i4], c0 * bfhi(a.x) + c1 * bfhi(bb.x) + c2 * o[dt][4 * i4 + 1]);
                w.y = pkc(c0 * bflo(a.y) + c1 * bflo(bb.y) + c2 * o[dt][4 * i4 + 2], c0 * bfhi(a.y) + c1 * bfhi(bb.y) + c2 * o[dt][4 * i4 + 3]);
                *(u32x2*)(dst + 32 * dt + 8 * i4) = w; }
    }
    LDS_BARRIER();
}

__device__ __forceinline__ void vt_build(const Args& A, Frame& F) {
    const int tid = F.tid;
    const float* kv = (const float*)(A.ws + WS_KVRAW);
    bf16_t* vt = (bf16_t*)(A.ws + WS_VT);
    LAS unsigned char* L = F.lds;
    for (int item = blockIdx.x; item < 256; item += gridDim.x) {
        const int bk = item >> 3, P0 = (item & 7) * 256, b = bk >> 2, kvh = bk & 3;
#pragma unroll 4
        for (int i = 0; i < 16; ++i) { const int e = tid + 512 * i, row = e >> 5, c4 = e & 31;
            const f32x4 v = *(const f32x4*)(kv + ((size_t)(b * SEQ + P0 + row)) * 1024 + 512 + kvh * 128 + 4 * c4);
            u32x2 w; w.x = pkc(v[0], v[1]); w.y = pkc(v[2], v[3]); *(LAS u32x2*)(L + row * 272 + c4 * 8) = w; }
        LDS_BARRIER();
#pragma unroll 2
        for (int i = 0; i < 8; ++i) { const int e = tid + 512 * i, d = e & 127;
            { const int ch = e >> 7;
              unsigned short x[8];
#pragma unroll
              for (int jj = 0; jj < 8; ++jj) x[jj] = *(const LAS unsigned short*)(L + (8 * ch + jj) * 272 + d * 2);
              u32x4 w; w.x = x[0] | ((unsigned)x[1] << 16); w.y = x[2] | ((unsigned)x[3] << 16); w.z = x[4] | ((unsigned)x[5] << 16); w.w = x[6] | ((unsigned)x[7] << 16);
              *(u32x4*)(vt + ((size_t)(bk * 128 + d)) * 2048 + P0 + 8 * ch) = w; }
            { const int c = (e >> 7) & 3, uc = e >> 9;
              unsigned short x[8];
#pragma unroll
              for (int jj = 0; jj < 8; ++jj) x[jj] = *(const LAS unsigned short*)(L + (4 * (8 * uc + jj) + c) * 272 + d * 2);
              u32x4 w; w.x = x[0] | ((unsigned)x[1] << 16); w.y = x[2] | ((unsigned)x[3] << 16); w.z = x[4] | ((unsigned)x[5] << 16); w.w = x[6] | ((unsigned)x[7] << 16);
              *(u32x4*)(vt + (size_t)MP * 512 + ((size_t)((bk * 4 + c) * 128 + d)) * 512 + (P0 >> 2) + 8 * uc) = w; }
            { const int c = (e >> 7) & 15, uc = e >> 11;
              unsigned short x[8];
#pragma unroll
              for (int jj = 0; jj < 8; ++jj) x[jj] = *(const LAS unsigned short*)(L + (16 * (8 * uc + jj) + c) * 272 + d * 2);
              u32x4 w; w.x = x[0] | ((unsigned)x[1] << 16); w.y = x[2] | ((unsigned)x[3] << 16); w.z = x[4] | ((unsigned)x[5] << 16); w.w = x[6] | ((unsigned)x[7] << 16);
              *(u32x4*)(vt + (size_t)2 * MP * 512 + ((size_t)((bk * 16 + c) * 128 + d)) * 128 + (P0 >> 4) + 8 * uc) = w; }
        }
        LDS_BARRIER();
    }
}
constexpr int G1_TOT = 4096, G1_QI = 8192, G1_KI = 25600, G1_VT = 43008;
constexpr int G2_QI = 0, G2_KET = 17408, G2_VT = 35840, G2_DEC = 72704, G2_SS = 73216, G2_ATT = 75264, G2_ONM = 84480;
__device__ __forceinline__ unsigned short f2bf_u(float x) { return (unsigned short)(pkc(x, 0.f) & 0xffffu); }

__device__ __forceinline__ void gla_g1_item(const Args& A, Frame& F, int l, int item) {
    const int tid = F.tid, lane = F.lane, wv = F.wave, r = lane & 31, hh = lane >> 5;
    const int b = item >> 5, n = item & 31, row0 = b * SEQ + 64 * n;
    LAS unsigned char* L = F.lds; LAS float* GL = (LAS float*)L; LAS float* TOT = (LAS float*)(L + G1_TOT);
    const bf16_t* proj = (const bf16_t*)(A.ws + WS_PROJ); const float* glr = (const float*)(A.ws + WS_GLR);
    bf16_t* qig = (bf16_t*)(A.ws + WS_QIG); bf16_t* ketg = (bf16_t*)(A.ws + WS_KETG); bf16_t* vtg = (bf16_t*)(A.ws + WS_VTG); float* decg = (float*)(A.ws + WS_DECG);
    bf16_t* on = (bf16_t*)(A.ws + WS_ON);
    for (int e = tid; e < 1024; e += 512) GL[e] = glr[(size_t)row0 * 16 + e];
    LDS_BARRIER();
    const int dk = tid & 127, tq = tid >> 7;
    for (int head = 0; head < 4; ++head) {
        const size_t idx = (size_t)item * 4 + head;
        float cl[16]; unsigned short qraw[16], kraw[16];
        {
            float w[16];
#pragma unroll
            for (int j = 0; j < 16; ++j) w[j] = A.in[9][(size_t)l * 16 * 512 + j * 512 + head * 128 + dk];
            const float bias = A.in[10][l * 512 + head * 128 + dk];
#pragma unroll
            for (int i = 0; i < 16; ++i) { const size_t row = (size_t)(row0 + 16 * tq + i); qraw[i] = proj[row * NPROJ + head * 128 + dk]; kraw[i] = proj[row * NPROJ + 512 + head * 128 + dk]; }
            float run = 0.f;
#pragma unroll
            for (int i = 0; i < 16; ++i) { const LAS float* gp = GL + (16 * tq + i) * 16; float z = bias;
#pragma unroll
                for (int q4 = 0; q4 < 4; ++q4) { const f32x4 gv = *(const LAS f32x4*)(gp + 4 * q4); z += (gv[0] * w[4 * q4] + gv[1] * w[4 * q4 + 1]) + (gv[2] * w[4 * q4 + 2] + gv[3] * w[4 * q4 + 3]); }
                const float ls = fminf(z, 0.f) - __logf(1.0f + __expf(-fabsf(z)));
                run += ls * (1.0f / 16.0f); cl[i] = run; }
            TOT[tq * 128 + dk] = run;
        }
#pragma unroll
        for (int i = 0; i < 4; ++i) { const int e = tid + 512 * i, t = e & 63, pc = e >> 6;
            const u32x4 v = *(const u32x4*)(proj + (size_t)(row0 + t) * NPROJ + 1024 + head * 256 + 8 * pc);
            LAS unsigned char* dst = L + G1_VT + (8 * pc) * 144 + 2 * t;
            *(LAS unsigned short*)(dst + 0 * 144) = (unsigned short)(v.x & 0xffffu); *(LAS unsigned short*)(dst + 1 * 144) = (unsigned short)(v.x >> 16);
            *(LAS unsigned short*)(dst + 2 * 144) = (unsigned short)(v.y & 0xffffu); *(LAS unsigned short*)(dst + 3 * 144) = (unsigned short)(v.y >> 16);
            *(LAS unsigned short*)(dst + 4 * 144) = (unsigned short)(v.z & 0xffffu); *(LAS unsigned short*)(dst + 5 * 144) = (unsigned short)(v.z >> 16);
            *(LAS unsigned short*)(dst + 6 * 144) = (unsigned short)(v.w & 0xffffu); *(LAS unsigned short*)(dst + 7 * 144) = (unsigned short)(v.w >> 16); }
        LDS_BARRIER();
        {
            float off = 0.f, last = 0.f;
#pragma unroll
            for (int q = 0; q < 4; ++q) { const float tv = TOT[q * 128 + dk]; last += tv; off += (q < tq) ? tv : 0.f; }
            unsigned short ke[16];
#pragma unroll
            for (int i = 0; i < 16; ++i) { const float cum = off + cl[i]; const int t = 16 * tq + i;
                const float q = bf2f(qraw[i]), k = bf2f(kraw[i]);
                const unsigned short qi = f2bf_u(q * __expf(cum)), ki = f2bf_u(k * __expf(-cum)); ke[i] = f2bf_u(k * __expf(last - cum));
                *(LAS unsigned short*)(L + G1_QI + t * 272 + 2 * dk) = qi; *(LAS unsigned short*)(L + G1_KI + t * 272 + 2 * dk) = ki;
                qig[(idx * 64 + t) * 128 + dk] = qi; }
            u32x4 k0, k1; k0.x = ke[0] | ((unsigned)ke[1] << 16); k0.y = ke[2] | ((unsigned)ke[3] << 16); k0.z = ke[4] | ((unsigned)ke[5] << 16); k0.w = ke[6] | ((unsigned)ke[7] << 16);
            k1.x = ke[8] | ((unsigned)ke[9] << 16); k1.y = ke[10] | ((unsigned)ke[11] << 16); k1.z = ke[12] | ((unsigned)ke[13] << 16); k1.w = ke[14] | ((unsigned)ke[15] << 16);
            bf16_t* kd = ketg + (idx * 128 + dk) * 64 + 16 * tq; *(u32x4*)kd = k0; *(u32x4*)(kd + 8) = k1;
            if (tq == 0) decg[idx * 128 + dk] = __expf(last);
        }
        LDS_BARRIER();
#pragma unroll
        for (int i = 0; i < 4; ++i) { const int e = tid + 512 * i, t = e >> 5, pc = e & 31;
            bf16_t* rp = (bf16_t*)proj + (size_t)(row0 + t) * NPROJ + 2048 + head * 256 + 8 * pc; const u32x4 rw = *(const u32x4*)rp;
            const float* gp = A.in[11] + l * 256 + 8 * pc; const f32x4 g0 = *(const f32x4*)gp, g1 = *(const f32x4*)(gp + 4);
            const float r0 = bflo(rw.x), r1 = bfhi(rw.x), r2 = bflo(rw.y), r3 = bfhi(rw.y), r4 = bflo(rw.z), r5 = bfhi(rw.z), r6 = bflo(rw.w), r7 = bfhi(rw.w);
            u32x4 o; o.x = pkc(r0 * pg8::fast_sigmoid(r0) * g0[0], r1 * pg8::fast_sigmoid(r1) * g0[1]); o.y = pkc(r2 * pg8::fast_sigmoid(r2) * g0[2], r3 * pg8::fast_sigmoid(r3) * g0[3]);
            o.z = pkc(r4 * pg8::fast_sigmoid(r4) * g1[0], r5 * pg8::fast_sigmoid(r5) * g1[1]); o.w = pkc(r6 * pg8::fast_sigmoid(r6) * g1[2], r7 * pg8::fast_sigmoid(r7) * g1[3]);
            *(u32x4*)rp = o; }
#pragma unroll
        for (int i = 0; i < 4; ++i) { const int e = tid + 512 * i, dv = e >> 3, pc = e & 7; *(u32x4*)(vtg + (idx * 256 + dv) * 64 + 8 * pc) = *(const LAS u32x4*)(L + G1_VT + dv * 144 + pc * 16); }
        if (wv < 3) {
            const int ta = wv == 2 ? 1 : 0, tb = wv == 0 ? 0 : 1;
            f32x16 at;
#pragma unroll
            for (int i = 0; i < 16; ++i) at[i] = 0.f;
#pragma unroll
            for (int s = 0; s < 8; ++s) {
                const bf16x8 kf = *(const LAS bf16x8*)(L + G1_KI + (32 * ta + r) * 272 + 32 * s + 16 * hh);
                const bf16x8 qf = *(const LAS bf16x8*)(L + G1_QI + (32 * tb + r) * 272 + 32 * s + 16 * hh);
                at = MFMA32(kf, qf, at); }
            if (ta == tb) {
#pragma unroll
                for (int i = 0; i < 16; ++i) { const int sl = (i & 3) + 8 * (i >> 2) + 4 * hh; if (sl > r) at[i] = 0.f; } }
            bf16_t* ad = (bf16_t*)(A.ws + WS_ATTG) + (idx * 64 + 32 * tb + r) * 64 + 32 * ta + 4 * hh;
#pragma unroll
            for (int i4 = 0; i4 < 4; ++i4) { u32x2 w; w.x = pkc(at[4 * i4], at[4 * i4 + 1]); w.y = pkc(at[4 * i4 + 2], at[4 * i4 + 3]); *(u32x2*)(ad + 8 * i4) = w; }
        }
        LDS_BARRIER();
    }
}

__device__ __forceinline__ void gla_g2_seq(const Args& A, Frame& F, int l, int bh) {
    const int tid = F.tid, lane = F.lane, wv = F.wave, r = lane & 31, hh = lane >> 5;
    const int b = bh >> 2, head = bh & 3;
    LAS unsigned char* L = F.lds;
    const bf16_t* proj = (const bf16_t*)(A.ws + WS_PROJ);
    const bf16_t* qig = (const bf16_t*)(A.ws + WS_QIG); const bf16_t* ketg = (const bf16_t*)(A.ws + WS_KETG); const bf16_t* vtg = (const bf16_t*)(A.ws + WS_VTG); const float* decg = (const float*)(A.ws + WS_DECG);
    bf16_t* on = (bf16_t*)(A.ws + WS_ON); const bf16_t* attg = (const bf16_t*)(A.ws + WS_ATTG);
    f32x16 S[4];
#pragma unroll
    for (int kt = 0; kt < 4; ++kt)
#pragma unroll
        for (int i = 0; i < 16; ++i) S[kt][i] = 0.f;
    u32x4 pq[2], pk[2], pv[4], pa; f32x4 pd = (f32x4){0.f, 0.f, 0.f, 0.f};
#define G2_LOAD(nn) do { const size_t idx_ = ((size_t)(b * 32 + (nn)) * 4 + head); \
        pq[0] = *(const u32x4*)(qig + idx_ * 8192 + (size_t)tid * 8); pq[1] = *(const u32x4*)(qig + idx_ * 8192 + (size_t)(tid + 512) * 8); \
        pk[0] = *(const u32x4*)(ketg + idx_ * 8192 + (size_t)tid * 8); pk[1] = *(const u32x4*)(ketg + idx_ * 8192 + (size_t)(tid + 512) * 8); \
        _Pragma("unroll") for (int i_ = 0; i_ < 4; ++i_) pv[i_] = *(const u32x4*)(vtg + idx_ * 16384 + (size_t)(tid + 512 * i_) * 8); \
        pa = *(const u32x4*)(attg + idx_ * 4096 + (size_t)tid * 8); \
        if (tid < 32) pd = *(const f32x4*)(decg + idx_ * 128 + tid * 4); } while (0)
#define G2_STORE() do { \
        _Pragma("unroll") for (int i_ = 0; i_ < 2; ++i_) { const int e_ = tid + 512 * i_; *(LAS u32x4*)(L + G2_QI + (e_ >> 4) * 272 + (e_ & 15) * 16) = pq[i_]; *(LAS u32x4*)(L + G2_KET + (e_ >> 3) * 144 + (e_ & 7) * 16) = pk[i_]; } \
        _Pragma("unroll") for (int i_ = 0; i_ < 4; ++i_) { const int e_ = tid + 512 * i_; *(LAS u32x4*)(L + G2_VT + (e_ >> 3) * 144 + (e_ & 7) * 16) = pv[i_]; } \
        *(LAS u32x4*)(L + G2_ATT + (tid >> 3) * 144 + (tid & 7) * 16) = pa; \
        if (tid < 32) *(LAS f32x4*)(L + G2_DEC + tid * 16) = pd; } while (0)
    G2_LOAD(0); G2_STORE(); LDS_BARRIER();
    for (int n = 0; n < 32; ++n) {
        asm volatile("; G2_STEP_BEGIN");
        if (n + 1 < 32) G2_LOAD(n + 1);
        const size_t rowa = (size_t)(b * SEQ + 64 * n + r), rowb = rowa + 32;
        u32x2 rr[2][4];
#pragma unroll
        for (int i4 = 0; i4 < 4; ++i4) { rr[0][i4] = *(const u32x2*)(proj + rowa * NPROJ + 2048 + head * 256 + 32 * wv + 8 * i4 + 4 * hh); rr[1][i4] = *(const u32x2*)(proj + rowb * NPROJ + 2048 + head * 256 + 32 * wv + 8 * i4 + 4 * hh); }
        __builtin_amdgcn_sched_barrier(0);
        f32x16 z0, z1;
#pragma unroll
        for (int i = 0; i < 16; ++i) { z0[i] = 0.f; z1[i] = 0.f; }
        bf16x8 vfr[4];
#pragma unroll
        for (int s = 0; s < 4; ++s) vfr[s] = *(const LAS bf16x8*)(L + G2_VT + (32 * wv + r) * 144 + (16 * s + 8 * hh) * 2);
#pragma unroll
        for (int s = 0; s < 4; ++s) {
            if (s < 2) { const bf16x8 af = *(const LAS bf16x8*)(L + G2_ATT + r * 144 + (16 * s + 8 * hh) * 2); z0 = MFMA32(vfr[s], af, z0); }
            const bf16x8 bfg = *(const LAS bf16x8*)(L + G2_ATT + (32 + r) * 144 + (16 * s + 8 * hh) * 2); z1 = MFMA32(vfr[s], bfg, z1); }
#pragma unroll
        for (int kt = 0; kt < 4; ++kt)
#pragma unroll
            for (int s = 0; s < 2; ++s) {
                const bf16x8 af = pack8(S[kt][8 * s], S[kt][8 * s + 1], S[kt][8 * s + 2], S[kt][8 * s + 3], S[kt][8 * s + 4], S[kt][8 * s + 5], S[kt][8 * s + 6], S[kt][8 * s + 7]);
                const LAS unsigned char* qp = L + G2_QI + r * 272 + (32 * kt + 16 * s + 4 * hh) * 2;
                { const u32x2 lo = *(const LAS u32x2*)(qp), hi = *(const LAS u32x2*)(qp + 16); u32x4 vv; vv.x = lo.x; vv.y = lo.y; vv.z = hi.x; vv.w = hi.y; z0 = MFMA32(af, __builtin_bit_cast(bf16x8, vv), z0); }
                { const u32x2 lo = *(const LAS u32x2*)(qp + 32 * 272), hi = *(const LAS u32x2*)(qp + 32 * 272 + 16); u32x4 vv; vv.x = lo.x; vv.y = lo.y; vv.z = hi.x; vv.w = hi.y; z1 = MFMA32(af, __builtin_bit_cast(bf16x8, vv), z1); }
            }
        asm volatile("" ::: "memory");
        bf16x8 vfu[4];
#pragma unroll
        for (int s = 0; s < 4; ++s) vfu[s] = *(const LAS bf16x8*)(L + G2_VT + (32 * wv + r) * 144 + (16 * s + 8 * hh) * 2);
#pragma unroll
        for (int kt = 0; kt < 4; ++kt) {
#pragma unroll
            for (int i4 = 0; i4 < 4; ++i4) { const f32x4 d4 = *(const LAS f32x4*)(L + G2_DEC + (32 * kt + 8 * i4 + 4 * hh) * 4);
                S[kt][4 * i4] *= d4[0]; S[kt][4 * i4 + 1] *= d4[1]; S[kt][4 * i4 + 2] *= d4[2]; S[kt][4 * i4 + 3] *= d4[3]; }
#pragma unroll
            for (int s = 0; s < 4; ++s) { const bf16x8 kf = *(const LAS bf16x8*)(L + G2_KET + (32 * kt + r) * 144 + (16 * s + 8 * hh) * 2); S[kt] = MFMA32(kf, vfu[s], S[kt]); }
        }
        float oa[16], ob[16]; float ssa = 0.f, ssb = 0.f;
#pragma unroll
        for (int i4 = 0; i4 < 4; ++i4) {
            oa[4 * i4] = z0[4 * i4]; oa[4 * i4 + 1] = z0[4 * i4 + 1]; oa[4 * i4 + 2] = z0[4 * i4 + 2]; oa[4 * i4 + 3] = z0[4 * i4 + 3];
            ob[4 * i4] = z1[4 * i4]; ob[4 * i4 + 1] = z1[4 * i4 + 1]; ob[4 * i4 + 2] = z1[4 * i4 + 2]; ob[4 * i4 + 3] = z1[4 * i4 + 3]; }
#pragma unroll
        for (int i = 0; i < 16; ++i) { ssa += oa[i] * oa[i]; ssb += ob[i] * ob[i]; }
        ssa += __shfl_xor(ssa, 32); ssb += __shfl_xor(ssb, 32);
        if (hh == 0) { *(LAS float*)(L + G2_SS + (wv * 64 + r) * 4) = ssa; *(LAS float*)(L + G2_SS + (wv * 64 + 32 + r) * 4) = ssb; }
        LDS_BARRIER();
        float ta = 0.f, tb = 0.f;
#pragma unroll
        for (int w = 0; w < 8; ++w) { ta += *(const LAS float*)(L + G2_SS + (w * 64 + r) * 4); tb += *(const LAS float*)(L + G2_SS + (w * 64 + 32 + r) * 4); }
        const float rsa = __builtin_amdgcn_rsqf(ta * (1.0f / 256.0f) + EPS), rsb = __builtin_amdgcn_rsqf(tb * (1.0f / 256.0f) + EPS);
#pragma unroll
        for (int i4 = 0; i4 < 4; ++i4) {
            u32x2 w; w.x = pkc(oa[4 * i4] * rsa * bflo(rr[0][i4].x), oa[4 * i4 + 1] * rsa * bfhi(rr[0][i4].x)); w.y = pkc(oa[4 * i4 + 2] * rsa * bflo(rr[0][i4].y), oa[4 * i4 + 3] * rsa * bfhi(rr[0][i4].y));
            *(u32x2*)(on + rowa * D + head * 256 + 32 * wv + 8 * i4 + 4 * hh) = w;
            u32x2 w2; w2.x = pkc(ob[4 * i4] * rsb * bflo(rr[1][i4].x), ob[4 * i4 + 1] * rsb * bfhi(rr[1][i4].x)); w2.y = pkc(ob[4 * i4 + 2] * rsb * bflo(rr[1][i4].y), ob[4 * i4 + 3] * rsb * bfhi(rr[1][i4].y));
            *(u32x2*)(on + rowb * D + head * 256 + 32 * wv + 8 * i4 + 4 * hh) = w2; }
        if (n + 1 < 32) G2_STORE();
        asm volatile("; G2_STEP_END");
        LDS_BARRIER();
    }
#undef G2_LOAD
#undef G2_STORE
    float* so = A.out + OUT_GSP + (((size_t)l * NBP + b) * 4 + head) * 128 * 256 + 32 * wv + r;
#pragma unroll
    for (int kt = 0; kt < 4; ++kt)
#pragma unroll
        for (int i = 0; i < 16; ++i) so[(size_t)(32 * kt + (i & 3) + 8 * (i >> 2) + 4 * hh) * 256] = S[kt][i];
}
constexpr int SA_QS = 0, SA_SC = 12672, SA_OG = 25344, SA_LSE = 49920, SA_STR = 132;
__device__ __forceinline__ int sa_slot(int idx) { return idx >= PAST ? 896 + (idx - PAST) : (idx >= 1536 ? idx - 1536 : 512 + ((idx >> 4) << 2) + (idx & 15)); }
__device__ __forceinline__ void satt_item(const Args& A, Frame& F, int j, int item) {
    const int tid = F.tid, lane = F.lane, wv = F.wave;
    const int b = item >> 2, kvh = item & 3;
    LAS float* qs = (LAS float*)(F.lds + SA_QS); LAS float* sc = (LAS float*)(F.lds + SA_SC); LAS float* og = (LAS float*)(F.lds + SA_OG); LAS float* lsel = (LAS float*)(F.lds + SA_LSE);
    const bf16_t* proj = (const bf16_t*)(A.ws + WS_PROJ);
    const bf16_t* ckp = (const bf16_t*)(A.ws + WS_CK) + (size_t)item * 900 * 128; const bf16_t* cvp = (const bf16_t*)(A.ws + WS_CV) + (size_t)item * 900 * 128;
    const float* qn = A.in[18] + j * 128;
#pragma unroll
    for (int k3 = 0; k3 < 3; ++k3) {
        const int qi = 3 * wv + k3, g = qi >> 3, t = (qi >> 1) & 3, hq = qi & 1; const int row = MP + TS * b + t; const int pos = PAST + t;
        const unsigned qw = *(const unsigned*)(proj + (size_t)row * NPROJ + g * 1024 + (kvh * 2 + hq) * 128 + 2 * lane);
        float q0 = bflo(qw), q1 = bfhi(qw);
        const float rs = __builtin_amdgcn_rsqf(wave_sum(q0 * q0 + q1 * q1) * (1.0f / 128.0f) + EPS);
        q0 *= rs * qn[2 * lane]; q1 *= rs * qn[2 * lane + 1];
        { const float o0 = __shfl_xor(q0, 8), o1 = __shfl_xor(q1, 8);
          if (lane < 16) { const int i0 = (2 * lane) & 15; const f32x4 cs = *(const f32x4*)((const float*)(A.ws + WS_ROPE) + ((size_t)pos * 16 + i0) * 2);
              if (lane < 8) { q0 = q0 * cs[0] - o0 * cs[1]; q1 = q1 * cs[2] - o1 * cs[3]; } else { q0 = q0 * cs[0] + o0 * cs[1]; q1 = q1 * cs[2] + o1 * cs[3]; } } }
        qs[qi * SA_STR + 2 * lane] = q0 * 0.08838834764831845f; qs[qi * SA_STR + 2 * lane + 1] = q1 * 0.08838834764831845f;
    }
    LDS_BARRIER();
    {
        const int r = lane & 31, h = lane >> 5;
        bf16x8 qf[8];
#pragma unroll
        for (int s2 = 0; s2 < 8; ++s2) { f32x4 a = (f32x4){0.f, 0.f, 0.f, 0.f}, c = a;
            if (r < 24) { a = *(const LAS f32x4*)(qs + r * SA_STR + 16 * s2 + 8 * h); c = *(const LAS f32x4*)(qs + r * SA_STR + 16 * s2 + 8 * h + 4); }
            qf[s2] = pack8(a[0], a[1], a[2], a[3], c[0], c[1], c[2], c[3]); }
#pragma unroll 2
        for (int k = 0; k < 8; ++k) { const int tt = wv + 8 * k;
            if (tt < 60) { const int L = tt / 5, p = tt - 5 * L, g = L >> 2, t = L & 3;
                int i = 32 * p + r; i = i > 128 ? 128 : i; const int idx = PAST + t - (i << (2 * g));
                const bf16_t* kr = ckp + (size_t)sa_slot(idx) * 128 + 8 * h;
                bf16x8 kf[8];
#pragma unroll
                for (int s2 = 0; s2 < 8; ++s2) kf[s2] = *(const bf16x8*)(kr + 16 * s2);
                f32x16 acc;
#pragma unroll
                for (int i2 = 0; i2 < 16; ++i2) acc[i2] = 0.f;
#pragma unroll
                for (int s2 = 0; s2 < 8; ++s2) acc = MFMA32(kf[s2], qf[s2], acc);
                if ((r >> 1) == L) { LAS float* dst = sc + r * SA_STR + 32 * p + 4 * h;
#pragma unroll
                    for (int i4 = 0; i4 < 4; ++i4) { if (32 * p + 8 * i4 + 4 * h + 3 <= 131) *(LAS f32x4*)(dst + 8 * i4) = (f32x4){acc[4 * i4], acc[4 * i4 + 1], acc[4 * i4 + 2], acc[4 * i4 + 3]}; } }
            }
        }
    }
    LDS_BARRIER();
#pragma unroll
    for (int k3 = 0; k3 < 3; ++k3) {
        const int qi = 3 * wv + k3; LAS float* row = sc + qi * SA_STR;
        const float a0 = row[lane], a1 = row[lane + 64], a2 = lane == 0 ? row[128] : -1e30f;
        const float mx = wave_max(fmaxf(fmaxf(a0, a1), a2));
        const float p0 = __expf(a0 - mx), p1 = __expf(a1 - mx), p2 = lane == 0 ? __expf(a2 - mx) : 0.f;
        const float sum = wave_sum(p0 + p1 + p2); const float inv = __builtin_amdgcn_rcpf(sum);
        row[lane] = p0 * inv; row[lane + 64] = p1 * inv; if (lane == 0) { row[128] = p2 * inv; lsel[qi] = mx + __logf(sum); }
    }
    LDS_BARRIER();
    if (tid < 384) {
        const int gt = tid >> 5, part = (tid >> 4) & 1, dl = tid & 15, g = gt >> 2, t = gt & 3;
        const LAS float* pa = sc + (gt * 2) * SA_STR; const LAS float* pb = pa + SA_STR;
        float acc0[8], acc1[8];
#pragma unroll
        for (int q = 0; q < 8; ++q) { acc0[q] = 0.f; acc1[q] = 0.f; }
        const int i0 = part ? 65 : 0, i1 = part ? 129 : 65;
#pragma unroll 13
        for (int i = i0; i < i1; ++i) { const int idx = PAST + t - (i << (2 * g));
            const u32x4 vw = *(const u32x4*)(cvp + (size_t)sa_slot(idx) * 128 + 8 * dl); const float p0 = pa[i], p1 = pb[i];
            const float v0 = bflo(vw.x), v1 = bfhi(vw.x), v2 = bflo(vw.y), v3 = bfhi(vw.y), v4 = bflo(vw.z), v5 = bfhi(vw.z), v6 = bflo(vw.w), v7 = bfhi(vw.w);
            acc0[0] += p0 * v0; acc0[1] += p0 * v1; acc0[2] += p0 * v2; acc0[3] += p0 * v3; acc0[4] += p0 * v4; acc0[5] += p0 * v5; acc0[6] += p0 * v6; acc0[7] += p0 * v7;
            acc1[0] += p1 * v0; acc1[1] += p1 * v1; acc1[2] += p1 * v2; acc1[3] += p1 * v3; acc1[4] += p1 * v4; acc1[5] += p1 * v5; acc1[6] += p1 * v6; acc1[7] += p1 * v7; }
        LAS float* o0 = og + (part * 24 + gt * 2) * 128 + 8 * dl; LAS float* o1 = o0 + 128;
        *(LAS f32x4*)o0 = (f32x4){acc0[0], acc0[1], acc0[2], acc0[3]}; *(LAS f32x4*)(o0 + 4) = (f32x4){acc0[4], acc0[5], acc0[6], acc0[7]};
        *(LAS f32x4*)o1 = (f32x4){acc1[0], acc1[1], acc1[2], acc1[3]}; *(LAS f32x4*)(o1 + 4) = (f32x4){acc1[4], acc1[5], acc1[6], acc1[7]};
    }
    LDS_BARRIER();
    {
        const int t = wv >> 1, hq = wv & 1;
        const float l0 = lsel[(0 * 4 + t) * 2 + hq], l1 = lsel[(1 * 4 + t) * 2 + hq], l2 = lsel[(2 * 4 + t) * 2 + hq];
        const float ml = fmaxf(fmaxf(l0, l1), l2); const float w0 = __expf(l0 - ml), w1 = __expf(l1 - ml), w2 = __expf(l2 - ml); const float wi = __builtin_amdgcn_rcpf(w0 + w1 + w2);
        const LAS float* o0 = og + ((0 * 4 + t) * 2 + hq) * 128 + 2 * lane; const LAS float* o1 = og + ((1 * 4 + t) * 2 + hq) * 128 + 2 * lane; const LAS float* o2 = og + ((2 * 4 + t) * 2 + hq) * 128 + 2 * lane;
        const float r0 = (w0 * (o0[0] + o0[24 * 128]) + w1 * (o1[0] + o1[24 * 128]) + w2 * (o2[0] + o2[24 * 128])) * wi, r1 = (w0 * (o0[1] + o0[24 * 128 + 1]) + w1 * (o1[1] + o1[24 * 128 + 1]) + w2 * (o2[1] + o2[24 * 128 + 1])) * wi;
        *(unsigned*)((bf16_t*)(A.ws + WS_ON) + (size_t)(MP + TS * b + t) * D + (kvh * 2 + hq) * 128 + 2 * lane) = pkc(r0, r1);
    }
    LDS_BARRIER();
}
typedef float sf32x4 __attribute__((ext_vector_type(4)));
struct SPre { float s; u32x2 x, p; };
struct SEpiScale {
    static constexpr bool SWIGLU = false;
    bf16_t* O; int ldc; const float* ssq; int col_f32; float* Fp; int ldf;
    __device__ __forceinline__ SPre prefetch(int row, int tn, int cg) const { SPre q; q.s = ssq ? pg8::rstd_of(ssq, row - MP) : 1.0f; q.x = (u32x2){0u, 0u}; q.p = q.x; return q; }
    __device__ __forceinline__ void apply(int row, int tn, int cg, sf32x4 v, const SPre& q) const {
        const int col = 32 * tn + 4 * cg; v = v * q.s;
        if (col >= col_f32) *(sf32x4*)(Fp + (size_t)row * ldf + (col - col_f32)) = v;
        else { u32x2 w; w.x = pkc(v[0], v[1]); w.y = pkc(v[2], v[3]); *(u32x2*)(O + (size_t)row * ldc + col) = w; }
    }
};
struct SEpiSwiglu {
    static constexpr bool SWIGLU = true;
    bf16_t* H; const float* ssq;
    __device__ __forceinline__ SPre prefetch(int row, int tn, int cg) const { SPre q; q.s = pg8::rstd_of(ssq, row - MP); q.x = (u32x2){0u, 0u}; q.p = q.x; return q; }
    __device__ __forceinline__ void apply(int row, int tn, int cg, sf32x4 v, const SPre& q) const {
        v = v * q.s;
        sf32x4 pv; pv[0] = __shfl_xor(v[0], 4); pv[1] = __shfl_xor(v[1], 4); pv[2] = __shfl_xor(v[2], 4); pv[3] = __shfl_xor(v[3], 4);
        if (cg < 4) { u32x2 w; w.x = pkc(v[0] * pg8::fast_sigmoid(v[0]) * pv[0], v[1] * pg8::fast_sigmoid(v[1]) * pv[1]); w.y = pkc(v[2] * pg8::fast_sigmoid(v[2]) * pv[2], v[3] * pg8::fast_sigmoid(v[3]) * pv[3]);
            *(u32x2*)(H + (size_t)row * FF + 16 * tn + 4 * cg) = w; }
    }
};
template <int MODE> struct SEpiRes {
    static constexpr bool SWIGLU = false;
    const bf16_t* Xin; bf16_t* XBo; float* ssq_out; const float* ssq_in; const bf16_t* PP; float* Yf;
    __device__ __forceinline__ SPre prefetch(int row, int tn, int cg) const { SPre q; const size_t off = (size_t)row * 1024 + 32 * tn + 4 * cg;
        q.x = *(const u32x2*)(Xin + off); q.s = 1.0f; q.p = (u32x2){0u, 0u};
        if (MODE == 1) { q.s = pg8::rstd_of(ssq_in, row - MP); q.p = *(const u32x2*)(PP + off); } return q; }
    __device__ __forceinline__ void apply(int row, int tn, int cg, sf32x4 v, const SPre& q) const {
        const size_t off = (size_t)row * 1024 + 32 * tn + 4 * cg;
        sf32x4 xv = (sf32x4){bflo(q.x.x), bfhi(q.x.x), bflo(q.x.y), bfhi(q.x.y)};
        if (MODE == 1) v = (sf32x4){bflo(q.p.x) * pg8::fast_sigmoid(v[0] * q.s), bfhi(q.p.x) * pg8::fast_sigmoid(v[1] * q.s), bflo(q.p.y) * pg8::fast_sigmoid(v[2] * q.s), bfhi(q.p.y) * pg8::fast_sigmoid(v[3] * q.s)};
        xv = xv + v;
        if (Yf) *(sf32x4*)(Yf + off) = xv;
        u32x2 w; w.x = pkc(xv[0], xv[1]); w.y = pkc(xv[2], xv[3]); *(u32x2*)(XBo + off) = w;
        float ss = (xv[0] * xv[0] + xv[1] * xv[1]) + (xv[2] * xv[2] + xv[3] * xv[3]);
        ss += __shfl_xor(ss, 1); ss += __shfl_xor(ss, 2); ss += __shfl_xor(ss, 4);
        if (cg == 0) atomicAdd(ssq_out + (size_t)(row - MP) * 16 + (tn >> 1), ss);
    }
};
struct STile { const bf16_t* ap; const bf16_t* bp0; const bf16_t* bp1; int tn, row0; };
template <class Epi> __device__ __forceinline__ STile stile_of(const bf16_t* A, const bf16_t* Bt, int K, int kw, int tile, int wv, int i16, int q) {
    STile t; const int tm = tile & 7; t.tn = tile >> 3; t.row0 = 64 * tm;
    int brow0, brow1;
    if (Epi::SWIGLU) { const int pn = t.tn >> 3, i0 = (t.tn & 7) * 16; brow0 = 256 * pn + i0; brow1 = brow0 + 128; } else { brow0 = 32 * t.tn; brow1 = brow0 + 16; }
    t.ap = A + (size_t)(t.row0 + i16) * K + wv * kw + 8 * q; t.bp0 = Bt + (size_t)(brow0 + i16) * K + wv * kw + 8 * q; t.bp1 = Bt + (size_t)(brow1 + i16) * K + wv * kw + 8 * q; return t; }
#define SG_LOADA(T, KS0, a_) do { _Pragma("unroll") for (int kk_ = 0; kk_ < 4; ++kk_) { if ((KS0) + kk_ < nks) { \
        _Pragma("unroll") for (int mt_ = 0; mt_ < 4; ++mt_) a_[kk_][mt_] = *(const bf16x8*)((T).ap + (size_t)(16 * mt_) * K + 32 * ((KS0) + kk_)); } } } while (0)
#define SG_LOADB(T, KS0, b0_, b1_) do { _Pragma("unroll") for (int kk_ = 0; kk_ < 4; ++kk_) { if ((KS0) + kk_ < nks) { \
        b0_[kk_] = *(const bf16x8*)((T).bp0 + 32 * ((KS0) + kk_)); b1_[kk_] = *(const bf16x8*)((T).bp1 + 32 * ((KS0) + kk_)); } } } while (0)
#define SG_MMA(KS0, a_, b0_, b1_) do { _Pragma("unroll") for (int kk_ = 0; kk_ < 4; ++kk_) { if ((KS0) + kk_ < nks) { \
        _Pragma("unroll") for (int mt_ = 0; mt_ < 4; ++mt_) { acc[mt_][0] = __builtin_amdgcn_mfma_f32_16x16x32_bf16(b0_[kk_], a_[kk_][mt_], acc[mt_][0], 0, 0, 0); acc[mt_][1] = __builtin_amdgcn_mfma_f32_16x16x32_bf16(b1_[kk_], a_[kk_][mt_], acc[mt_][1], 0, 0, 0); } } } } while (0)
template <class Epi> __device__ __forceinline__ void sgemm_tiles(Frame& F, const bf16_t* A, const bf16_t* Bt, int N, int K, const Epi& E, int tile0, int tstride) {
    const int lane = F.lane, wv = F.wave, i16 = lane & 15, q = lane >> 4, tid = F.tid, rr = tid >> 3, cg = tid & 7;
    const int ntiles = 8 * (N >> 5), kw = K >> 3, nks = kw >> 5;
    if (tile0 >= ntiles) return;
    const bool keepa = (tstride & 7) == 0;
    LAS float* P = (LAS float*)F.lds;
    bf16x8 fa[4][4], fb0[4], fb1[4];
    STile cur = stile_of<Epi>(A, Bt, K, kw, tile0, wv, i16, q);
    SPre pre = E.prefetch(MP + cur.row0 + rr, cur.tn, cg);
    SG_LOADA(cur, 0, fa); SG_LOADB(cur, 0, fb0, fb1);
    for (int tile = tile0; tile < ntiles; tile += tstride) {
        sf32x4 acc[4][2];
#pragma unroll
        for (int mt = 0; mt < 4; ++mt) { acc[mt][0] = (sf32x4){0.f, 0.f, 0.f, 0.f}; acc[mt][1] = (sf32x4){0.f, 0.f, 0.f, 0.f}; }
        SG_MMA(0, fa, fb0, fb1);
        for (int ks0 = 4; ks0 < nks; ks0 += 4) { bf16x8 ga[4][4], gb0[4], gb1[4]; SG_LOADA(cur, ks0, ga); SG_LOADB(cur, ks0, gb0, gb1); SG_MMA(ks0, ga, gb0, gb1); }
        const int nt = tile + tstride; const bool hn = nt < ntiles;
        const STile nx = stile_of<Epi>(A, Bt, K, kw, hn ? nt : tile, wv, i16, q);
        const SPre cpre = pre;
        if (hn) { pre = E.prefetch(MP + nx.row0 + rr, nx.tn, cg); if (!keepa) SG_LOADA(nx, 0, fa); SG_LOADB(nx, 0, fb0, fb1); }
#pragma unroll
        for (int mt = 0; mt < 4; ++mt) { *(LAS sf32x4*)(P + ((wv * 64 + 16 * mt + i16) * 36 + 4 * q)) = acc[mt][0]; *(LAS sf32x4*)(P + ((wv * 64 + 16 * mt + i16) * 36 + 16 + 4 * q)) = acc[mt][1]; }
        LDS_BARRIER();
        sf32x4 v = (sf32x4){0.f, 0.f, 0.f, 0.f};
#pragma unroll
        for (int w = 0; w < 8; ++w) v = v + *(const LAS sf32x4*)(P + ((w * 64 + rr) * 36 + 4 * cg));
        E.apply(MP + cur.row0 + rr, cur.tn, cg, v, cpre);
        LDS_BARRIER();
        cur = nx;
    }
}
#undef SG_LOADA
#undef SG_LOADB
#undef SG_MMA
template <class Epi> __device__ __forceinline__ void sgemm_tiles_from(Frame& F, const bf16_t* A, const bf16_t* Bt, int N, int K, const Epi& E, int tile0, int tstride) { sgemm_tiles<Epi>(F, A, Bt, N, K, E, tile0, tstride); }
constexpr int PH_P0 = 0, PH_A0 = 1, PH_B0 = 15, NPHASE = 30;

__global__ void __launch_bounds__(NWAVES * 64, 2) mk_fwd(Args args) {
    extern __shared__ __attribute__((aligned(16))) unsigned char lds[];
    Frame F;
    F.lds = (LAS unsigned char*)lds;
    F.tid = threadIdx.x; F.lane = F.tid & 63; F.wave = __builtin_amdgcn_readfirstlane(F.tid >> 6);
    F.G = gridDim.x; { const int bx = blockIdx.x; F.vcu = (F.G % 8 == 0) ? (bx % 8) * (F.G / 8) + bx / 8 : bx; }
    volatile LAS unsigned* MISC = (volatile LAS unsigned*)(F.lds + MISC_OFF);
    for (int u = F.tid; u < (LDS_BYTES - LDSCTL_OFF) / 4; u += NWAVES * 64) ((LAS unsigned*)(F.lds + LDSCTL_OFF))[u] = 0u;
    __syncthreads();
    unsigned* ctl = (unsigned*)(args.ws + WS_CTL);
    XcdBarrier bar; bar.bar = ctl + CW_BAR; bar.x = 0; bar.st = nullptr;
    if (args.use_bar) bar = xcd_barrier_post(ctl + CW_BAR, MISC + 8);
    const int lo = args.ph_lo, hi = args.ph_hi;
#ifndef MK_DUP
#define MK_DUP (-1)
#endif
#define IN(k) (lo <= (k) && (k) < hi)
#define SEAM(k) do { if (IN(k) && IN((k) + 1)) { xcd_barrier(bar); if (MK_DUP == 19) xcd_barrier(bar); } } while (0)
#define DUP(t) for (int dup_ = 0; dup_ < ((MK_DUP == (t)) ? 2 : 1); ++dup_)
    unsigned char* ws = args.ws;
    float* X = args.out + OUT_Y;
    float* SSQM = (float*)(ws + WS_SSQM); float* SSQSA = (float*)(ws + WS_SSQ);
#define SSQP(v) (SSQM + (size_t)(v) * MP * 16)
#define SSQS(v) (SSQSA + (size_t)(v) * MS * 16)
    bf16_t* XB = (bf16_t*)(ws + WS_XB);
    bf16_t* PROJ = (bf16_t*)(ws + WS_PROJ); bf16_t* H = (bf16_t*)(ws + WS_H); bf16_t* ON = (bf16_t*)(ws + WS_ON);
    bf16_t* PP = (bf16_t*)(ws + WS_PP); bf16_t* PB = (bf16_t*)(ws + WS_PB);
    const int bx = (int)blockIdx.x;

    if (IN(PH_P0)) { DUP(0) { p0_prologue(args, F); __syncthreads(); } }
    SEAM(PH_P0);
#define PP_SITE(i, c_, G_) { { SEpiScale SE{PP + (size_t)(i) * MT * 1024, 1024, nullptr, 1 << 30, nullptr, 0}; \
              sgemm_tiles<SEpiScale>(F, PB + ((size_t)(i) * MT + MP) * PLE, (const bf16_t*)(ws + WS_WPROJ) + (size_t)(i) * 1024 * PLE, 1024, PLE, SE, (c_), (G_)); } \
            pg8::Gemm g{PB + (size_t)(i) * MT * PLE, (const bf16_t*)(ws + WS_WPROJ) + (size_t)(i) * 1024 * PLE, MP, 1024, PLE}; pg8::StaticOrder S; S.init(MP, 1024, (G_), (c_)); \
            pg8::EpiScale E{PP + (size_t)(i) * MT * 1024, 1024, nullptr, 1 << 30, nullptr, 0}; \
            pg8::gemm_phase<pg8::EpiScale, pg8::StaticOrder, true, true>(F.lds, g, S, E); }

#define CHANNEL_PHASES(phbase, layer, WoT)                                                                                                   \
    if (IN((phbase) + 0)) {                                                                            \
        { SEpiRes<0> SE{XB, XB + (size_t)1 * MT * D, SSQS(3 * (layer) + 1), nullptr, nullptr, nullptr};                                  \
          sgemm_tiles<SEpiRes<0>>(F, ON + (size_t)MP * D, (WoT), 1024, 1024, SE, bx, F.G); }                                                  \
        pg8::Gemm g{ON, (WoT), MP, 1024, 1024}; pg8::StaticOrder S; S.init(MP, 1024, F.G, bx);                                               \
        pg8::EpiRes<0> E{XB, XB + (size_t)1 * MT * D, SSQP(3 * (layer) + 1), nullptr, nullptr, nullptr};                                  \
        pg8::gemm_phase<pg8::EpiRes<0>, pg8::StaticOrder, true, true>(F.lds, g, S, E); if (MK_DUP == 18) { pg8::EpiScale Ed{(bf16_t*)(ws + WS_OG), 1024, nullptr, 1 << 30, nullptr, 0}; pg8::gemm_phase<pg8::EpiScale, pg8::StaticOrder, true, true>(F.lds, g, S, Ed); } }                                                      \
    SEAM((phbase) + 0);                                                                                                                      \
    if (IN((phbase) + 1)) {                                                                               \
        { SEpiSwiglu SE{H, SSQS(3 * (layer) + 1)};     \
          if (F.G == 256) { if (bx < 128) DUP(15) sgemm_tiles<SEpiSwiglu>(F, XB + ((size_t)1 * MT + MP) * D, (const bf16_t*)(ws + WS_WFIN) + (size_t)(layer) * 5632 * 1024, 1 * 128 * 32 / 8, 1024, SE, bx, 128);   \
              else DUP(15) sgemm_tiles_from<SEpiSwiglu>(F, XB + ((size_t)1 * MT + MP) * D, (const bf16_t*)(ws + WS_WFIN) + (size_t)(layer) * 5632 * 1024, 5632, 1024, SE, 128 + (bx - 128), 128); }                    \
          else DUP(15) sgemm_tiles<SEpiSwiglu>(F, XB + ((size_t)1 * MT + MP) * D, (const bf16_t*)(ws + WS_WFIN) + (size_t)(layer) * 5632 * 1024, 5632, 1024, SE, bx, F.G); }                                           \
        pg8::Gemm g{XB + (size_t)1 * MT * D, (const bf16_t*)(ws + WS_WFIN) + (size_t)(layer) * 5632 * 1024, MP, 5632, 1024}; pg8::StaticOrder S; S.init(MP, 5632, F.G, bx); \
        pg8::EpiSwiglu E{H, FF, SSQP(3 * (layer) + 1)};                                                                       \
        pg8::gemm_phase<pg8::EpiSwiglu, pg8::StaticOrder, true, true>(F.lds, g, S, E); if (MK_DUP == 16) pg8::gemm_phase<pg8::EpiSwiglu, pg8::StaticOrder, true, true>(F.lds, g, S, E); }                                                      \
    SEAM((phbase) + 1);                                                                                                                      \
    if (IN((phbase) + 2)) {                                                                         \
        { SEpiRes<0> SE{XB + (size_t)1 * MT * D, XB + (size_t)2 * MT * D, SSQS(3 * (layer) + 2), nullptr, nullptr, nullptr};                                  \
          sgemm_tiles<SEpiRes<0>>(F, H + (size_t)MP * FF, (const bf16_t*)(ws + WS_WFOUT) + (size_t)(layer) * 1024 * FF, 1024, FF, SE, bx, F.G); } \
        pg8::Gemm g{H, (const bf16_t*)(ws + WS_WFOUT) + (size_t)(layer) * 1024 * FF, MP, 1024, FF}; pg8::StaticOrder S; S.init(MP, 1024, F.G, bx); \
        pg8::EpiRes<0> E{XB + (size_t)1 * MT * D, XB + (size_t)2 * MT * D, SSQP(3 * (layer) + 2), nullptr, nullptr, nullptr};                                  \
        pg8::gemm_phase<pg8::EpiRes<0>, pg8::StaticOrder, true, true>(F.lds, g, S, E); if (MK_DUP == 18) { pg8::EpiScale Ed{(bf16_t*)(ws + WS_OG), 1024, nullptr, 1 << 30, nullptr, 0}; pg8::gemm_phase<pg8::EpiScale, pg8::StaticOrder, true, true>(F.lds, g, S, Ed); } }                                                      \
    SEAM((phbase) + 2);                                                                                                                      \
    if (IN((phbase) + 3)) {                                                      \
        { SEpiRes<1> SE{XB + (size_t)2 * MT * D, XB, SSQS(3 * (layer) + 3), SSQS(3 * (layer) + 2), PP + (size_t)(layer) * MT * 1024, (layer) == 3 ? X : nullptr};   \
          sgemm_tiles<SEpiRes<1>>(F, XB + ((size_t)2 * MT + MP) * D, (const bf16_t*)(ws + WS_WGATE) + (size_t)(layer) * 1024 * 1024, 1024, 1024, SE, bx, F.G); } \
        pg8::Gemm g{XB + (size_t)2 * MT * D, (const bf16_t*)(ws + WS_WGATE) + (size_t)(layer) * 1024 * 1024, MP, 1024, 1024}; pg8::StaticOrder S; S.init(MP, 1024, F.G, bx); \
        pg8::EpiRes<1> E{XB + (size_t)2 * MT * D, XB, SSQP(3 * (layer) + 3), SSQP(3 * (layer) + 2), PP + (size_t)(layer) * MT * 1024, (layer) == 3 ? X : nullptr};   \
        pg8::gemm_phase<pg8::EpiRes<1>, pg8::StaticOrder, true, true>(F.lds, g, S, E); if (MK_DUP == 18) { pg8::EpiScale Ed{(bf16_t*)(ws + WS_OG), 1024, nullptr, 1 << 30, nullptr, 0}; pg8::gemm_phase<pg8::EpiScale, pg8::StaticOrder, true, true>(F.lds, g, S, Ed); } }                                                      \
    SEAM((phbase) + 3);

#if !defined(NO_A)
#define A_LAYER(LIDX) { \
        constexpr int l = LIDX; constexpr int pb = PH_A0 + 7 * l; \
        if (IN(pb + 0)) { \
            { SEpiScale SE{PROJ, NPROJ, SSQS(3 * l), 1 << 30, nullptr, 0}; \
              DUP(15) sgemm_tiles<SEpiScale>(F, XB + (size_t)MP * D, (const bf16_t*)(ws + WS_WIN) + (size_t)l * 3072 * 1024, 3072, 1024, SE, bx, F.G); } \
            pg8::Gemm g{XB, (const bf16_t*)(ws + WS_WIN) + (size_t)l * 3072 * 1024, MP, 3072, 1024}; pg8::StaticOrder S; S.init(MP, 3072, F.G, bx); \
            pg8::EpiScale E{PROJ, NPROJ, SSQP(3 * l), 1 << 30, nullptr, 0}; \
            pg8::gemm_phase<pg8::EpiScale, pg8::StaticOrder, true, true>(F.lds, g, S, E); if (MK_DUP == 16) pg8::gemm_phase<pg8::EpiScale, pg8::StaticOrder, true, true>(F.lds, g, S, E); \
            DUP(14) glr_rows(args, F, l, XB, SSQP(3 * l), SSQS(3 * l)); \
        } \
        SEAM(pb + 0); \
        if (IN(pb + 1)) { \
            DUP(11) for (int it = bx; it < 256; it += F.G) gla_g1_item(args, F, l, it); \
        } \
        SEAM(pb + 1); \
        if (IN(pb + 2)) { \
            for (int bh = bx; bh < 32; bh += F.G) gla_g2_seq(args, F, l, bh); \
            const int ns = F.G > 32 ? F.G - 32 : F.G, sb0 = F.G > 32 ? bx - 32 : bx; \
            if (sb0 >= 0) { DUP(12) for (int it = sb0; it < 512; it += ns) gla_naive_item(args, F, l, it); \
                DUP(17) cache_compact(args, F, l, sb0 * NWAVES + F.wave, ns * NWAVES); \
                __syncthreads(); \
                PP_SITE(2 * l, sb0, ns) PP_SITE(2 * l + 1, sb0, ns) } \
        } \
        SEAM(pb + 2); \
        if (MK_DUP == 3 && IN(pb + 1) && IN(pb + 2)) { \
            for (int it = bx; it < 256; it += F.G) gla_g1_item(args, F, l, it); \
            xcd_barrier(bar); \
            for (int bh = bx; bh < 32; bh += F.G) gla_g2_seq(args, F, l, bh); \
            xcd_barrier(bar); \
        } \
        CHANNEL_PHASES(pb + 3, l, (const bf16_t*)(ws + WS_WAO) + (size_t)l * 1024 * 1024) }
    A_LAYER(0)
    A_LAYER(1)
#undef A_LAYER
#endif
#if !defined(NO_B)
#define B_LAYER(JIDX) { \
        constexpr int j = JIDX; constexpr int pb = PH_B0 + 8 * j, layer = 2 + j; constexpr int pa = pb + 1 - j;     \
        if (IN(pb + 0)) { \
            if (j == 0) { \
                { SEpiScale SE{PROJ, NPROJ, SSQS(3 * layer), 3072, (float*)(ws + WS_KVRAW), 1024}; \
                  DUP(15) sgemm_tiles<SEpiScale>(F, XB + (size_t)MP * D, (const bf16_t*)(ws + WS_WQKV), 4096, 1024, SE, bx, F.G); } \
                pg8::Gemm g{XB, (const bf16_t*)(ws + WS_WQKV), MP, 4096, 1024}; pg8::StaticOrder S; S.init(MP, 4096, F.G, bx); \
                pg8::EpiScale E{PROJ, NPROJ, SSQP(3 * layer), 12, (float*)(ws + WS_KVRAW), 1024}; \
                pg8::gemm_phase<pg8::EpiScale, pg8::StaticOrder, true, true>(F.lds, g, S, E); if (MK_DUP == 16) pg8::gemm_phase<pg8::EpiScale, pg8::StaticOrder, true, true>(F.lds, g, S, E); \
            } else { \
                { SEpiScale SE{PROJ, NPROJ, SSQS(3 * layer), 1 << 30, nullptr, 0}; \
                  DUP(15) sgemm_tiles<SEpiScale>(F, XB + (size_t)MP * D, (const bf16_t*)(ws + WS_WQ1), 3072, 1024, SE, bx, F.G); } \
                pg8::Gemm g{XB, (const bf16_t*)(ws + WS_WQ1), MP, 3072, 1024}; pg8::StaticOrder S; S.init(MP, 3072, F.G, bx); \
                pg8::EpiScale E{PROJ, NPROJ, SSQP(3 * layer), 1 << 30, nullptr, 0}; \
                pg8::gemm_phase<pg8::EpiScale, pg8::StaticOrder, true, true>(F.lds, g, S, E); if (MK_DUP == 16) pg8::gemm_phase<pg8::EpiScale, pg8::StaticOrder, true, true>(F.lds, g, S, E); \
            } \
        } \
        SEAM(pb + 0); \
        if (j == 0) { if (IN(pb + 1)) { DUP(6) { kn_rows(args, F); vt_build(args, F); } } \
            SEAM(pb + 1); } \
        if (IN(pa + 1)) { DUP(4) for (int v = bx; v < 1024; v += F.G) att_unit<false>(args, F, j, v < 512 ? v : v + 512);     DUP(13) for (int it = bx; it < 256; it += F.G) satt_item(args, F, j, it); } \
        SEAM(pa + 1); \
        if (IN(pa + 2)) { DUP(5) for (int un = 512 + bx; un < 1024; un += F.G) att_unit<true>(args, F, j, un);     DUP(13) for (int it = 256 + bx; it < 512; it += F.G) satt_item(args, F, j, it); } \
        SEAM(pa + 2); \
        CHANNEL_PHASES(pa + 3, layer, (const bf16_t*)(ws + WS_WBO) + (size_t)j * 1024 * 1024) }
    B_LAYER(0)
    B_LAYER(1)
#undef B_LAYER
#endif
#undef CHANNEL_PHASES
#undef IN
#undef SEAM
}
}

#ifndef MK_ONE_LAUNCH
#define MK_ONE_LAUNCH 0
#endif
extern "C" void kernel_launch(void* const* d_in, const int* in_sizes, int n_in, void* d_out, int out_size, void* d_ws, size_t ws_size, hipStream_t stream) {
    using namespace mk;
    static int grid = 0;
    if (grid == 0) {
        if (n_in != 26 || out_size != 70254592 || ws_size < WS_END) { fprintf(stderr, "kernel_launch: unexpected problem shape (n_in %d, out %d, ws %zu, need %zu)\n", n_in, out_size, ws_size, (size_t)WS_END); grid = -1; return; }
        int dev = 0, cus = 0, per_cu = 0;
        if (hipGetDevice(&dev) != hipSuccess || hipDeviceGetAttribute(&cus, hipDeviceAttributeMultiprocessorCount, dev) != hipSuccess) { grid = -1; return; }
        if (hipFuncSetAttribute((const void*)mk_fwd, hipFuncAttributeMaxDynamicSharedMemorySize, LDS_BYTES) != hipSuccess) { fprintf(stderr, "kernel_launch: hipFuncSetAttribute failed\n"); grid = -1; return; }
        if (hipOccupancyMaxActiveBlocksPerMultiprocessor(&per_cu, (const void*)mk_fwd, NWAVES * 64, LDS_BYTES) != hipSuccess || per_cu < 1) { fprintf(stderr, "kernel_launch: occupancy query says %d\n", per_cu); }
        (void)hipGetLastError();
        grid = cus;
    }
    if (grid < 0) return;
    if (hipMemsetAsync((char*)d_ws + WS_CTL, 0, CTL_BYTES, stream) != hipSuccess) return;
    Args a{};
    for (int i = 0; i < 26; ++i) a.in[i] = (const float*)d_in[i];
    a.out = (float*)d_out; a.ws = (unsigned char*)d_ws;
#if MK_ONE_LAUNCH
    a.ph_lo = 0; a.ph_hi = NPHASE; a.use_bar = 1; a.pad = 0;
    hipLaunchKernelGGL(mk_fwd, dim3(grid), dim3(NWAVES * 64), LDS_BYTES, stream, a);
#else
    for (int p = 0; p < NPHASE; ++p) { a.ph_lo = p; a.ph_hi = p + 1; a.use_bar = 0; a.pad = 0;
        hipLaunchKernelGGL(mk_fwd, dim3(grid), dim3(NWAVES * 64), LDS_BYTES, stream, a); }
#endif
}
```

```cpp
#include <hip/hip_runtime.h>
#include <cstdio>
#include <cstdint>
#include <hip/hip_bf16.h>
#ifndef MK_ONE_LAUNCH
#define MK_ONE_LAUNCH 1
#endif
namespace pg8 {
#define PG8_LAS __attribute__((address_space(3)))
typedef unsigned short bf16_t;
typedef short bf16x8 __attribute__((ext_vector_type(8)));
typedef float f32x4 __attribute__((ext_vector_type(4)));
typedef unsigned u32x4 __attribute__((ext_vector_type(4)));
constexpr int BM = 256, BK = 64, HALF = 128, HTB = HALF * BK * 2  , STAGE_BYTES = 8 * HTB, NXCD = 8, WGM = 8;

__host__ __device__ __forceinline__ int lds_byte(int r, int c) { const int st = (r >> 4) * 2 + (c >> 5), rr = r & 15, cc = c & 31, ob = rr * 64 + cc * 2; return st * 1024 + (ob ^ (((ob >> 9) & 1) << 5)); }
__host__ __device__ __forceinline__ void stage_rc(int b, int& R, int& C) { const int st = b / 1024, sb = b % 1024, swz = sb ^ (((sb >> 9) & 1) << 5); R = (st >> 1) * 16 + swz / 64; C = (st & 1) * 32 + (swz % 64) / 2; }
__host__ __device__ __forceinline__ int perm32(int rho) { const int n = rho >> 4, i = rho & 15; return 8 * (i >> 2) + 4 * n + (i & 3); }

struct Unit { int pm, pn; };
struct Gemm { const bf16_t* A; const bf16_t* Bt; int M, N, K; };

struct StaticOrder {
    int nM, nN, nwg, G, c;
    __host__ __device__ void init(int M, int N, int G_, int c_) { nM = M / BM; nN = N / BM; nwg = nM * nN; G = G_; c = c_; }
    __host__ __device__ bool next(int i, Unit& u) const {
        const long L = (long)i * G + c; if (L >= nwg) return false;
        int wgid = (int)L; { const int q = nwg / NXCD, r = nwg % NXCD, xcd = wgid % NXCD, off = wgid / NXCD; wgid = (xcd < r ? xcd * (q + 1) : r * (q + 1) + (xcd - r) * q) + off; }
        const int nig = WGM * nN, gid = wgid / nig, fm = gid * WGM, gsz = (nM - fm) < WGM ? (nM - fm) : WGM;
        u.pm = fm + ((wgid % nig) % gsz); u.pn = (wgid % nig) / gsz; return true;
    }
    __device__ __forceinline__ void a_ready(const Unit&) const {}
    __device__ __forceinline__ void done(const Unit&) const {}
};
__device__ __forceinline__ unsigned cvt_pk_bf16(float lo, float hi) { unsigned r; asm volatile("v_cvt_pk_bf16_f32 %0, %1, %2" : "=v"(r) : "v"(lo), "v"(hi)); return r; }
constexpr float RMS_EPS = 1e-6f;
__device__ __forceinline__ float rstd_of(const float* ssq16, int r) { const f32x4* p = (const f32x4*)(ssq16 + (size_t)r * 16); const f32x4 a = p[0], b = p[1], c = p[2], d = p[3];
    const float t = ((a[0] + a[1]) + (a[2] + a[3])) + ((b[0] + b[1]) + (b[2] + b[3])) + (((c[0] + c[1]) + (c[2] + c[3])) + ((d[0] + d[1]) + (d[2] + d[3])));
    return __builtin_amdgcn_rsqf(t * (1.0f / 1024.0f) + RMS_EPS); }
__device__ __forceinline__ float fast_sigmoid(float x) { return __builtin_amdgcn_rcpf(1.0f + __expf(-x)); }

struct EpiScale {
    static constexpr bool PERM = true, AFTER_DRAIN = false;
    bf16_t* O; int ldc; const float* ssq; int pn_f32; float* F; int ldf;
    __device__ __forceinline__ void operator()(const f32x4 (&acc)[2][2][4][2], const Unit& u, int wr, int wc, int fr, int fq) const {
        const int row0 = u.pm * BM + wr * 64 + fr;
        const bool tof32 = u.pn >= pn_f32;
        const int col0 = (tof32 ? (u.pn - pn_f32) : u.pn) * BM + wc * 32 + 8 * fq;
#pragma unroll
        for (int ai = 0; ai < 2; ++ai)
#pragma unroll
            for (int m = 0; m < 4; ++m) { const int r = row0 + ai * HALF + m * 16; const float s = ssq ? rstd_of(ssq, r) : 1.0f;
#pragma unroll
                for (int bj = 0; bj < 2; ++bj) { const f32x4 v0 = acc[ai][bj][m][0] * s, v1 = acc[ai][bj][m][1] * s;
                    if (tof32) { float* p = F + (size_t)r * ldf + col0 + bj * HALF; *(f32x4*)p = v0; *(f32x4*)(p + 4) = v1; }
                    else { u32x4 w; w.x = cvt_pk_bf16(v0[0], v0[1]); w.y = cvt_pk_bf16(v0[2], v0[3]); w.z = cvt_pk_bf16(v1[0], v1[1]); w.w = cvt_pk_bf16(v1[2], v1[3]);
                        *(u32x4*)(O + (size_t)r * ldc + col0 + bj * HALF) = w; } } }
    }
};
struct EpiSwiglu {
    static constexpr bool PERM = true, AFTER_DRAIN = false;
    bf16_t* H; int ldh; const float* ssq;
    __device__ __forceinline__ void operator()(const f32x4 (&acc)[2][2][4][2], const Unit& u, int wr, int wc, int fr, int fq) const {
        const int row0 = u.pm * BM + wr * 64 + fr, col0 = u.pn * HALF + wc * 32 + 8 * fq;
#pragma unroll
        for (int ai = 0; ai < 2; ++ai)
#pragma unroll
            for (int m = 0; m < 4; ++m) { const int r = row0 + ai * HALF + m * 16; const float s = rstd_of(ssq, r);
                float h[8];
#pragma unroll
                for (int n = 0; n < 2; ++n)
#pragma unroll
                    for (int j = 0; j < 4; ++j) { const float a = acc[ai][0][m][n][j] * s, b = acc[ai][1][m][n][j] * s; h[n * 4 + j] = a * fast_sigmoid(a) * b; }
                u32x4 w; w.x = cvt_pk_bf16(h[0], h[1]); w.y = cvt_pk_bf16(h[2], h[3]); w.z = cvt_pk_bf16(h[4], h[5]); w.w = cvt_pk_bf16(h[6], h[7]);
                *(u32x4*)(H + (size_t)r * ldh + col0) = w; }
    }
};
template <int MODE> struct EpiRes {
    static constexpr bool PERM = false, AFTER_DRAIN = false;
    const bf16_t* Xin; bf16_t* XBo; float* ssq_out; const float* ssq_in; const bf16_t* PP; float* Yf;
    __device__ __forceinline__ void operator()(const f32x4 (&acc)[2][2][4][2], const Unit& u, int wr, int wc, int fr, int fq) const {
        typedef unsigned u32x2 __attribute__((ext_vector_type(2)));
        const int row0 = u.pm * BM + wr * 64 + fr, col0 = u.pn * BM + wc * 32 + 4 * fq;
#pragma unroll
        for (int ai = 0; ai < 2; ++ai)
#pragma unroll
            for (int m = 0; m < 4; ++m) { const int r = row0 + ai * HALF + m * 16; float ss = 0.f; float s = 1.f; if (MODE == 1) s = rstd_of(ssq_in, r);
#pragma unroll
                for (int bj = 0; bj < 2; ++bj)
#pragma unroll
                    for (int n = 0; n < 2; ++n) { const size_t off = (size_t)r * 1024 + col0 + bj * HALF + n * 16;
                        const u32x2 xw = *(const u32x2*)(Xin + off);
                        f32x4 xv = (f32x4){__uint_as_float(xw.x << 16), __uint_as_float(xw.x & 0xffff0000u), __uint_as_float(xw.y << 16), __uint_as_float(xw.y & 0xffff0000u)};
                        f32x4 d = acc[ai][bj][m][n];
                        if (MODE == 1) { const u32x2 pw = *(const u32x2*)(PP + off);
                            const float p0 = __uint_as_float(pw.x << 16), p1 = __uint_as_float(pw.x & 0xffff0000u), p2 = __uint_as_float(pw.y << 16), p3 = __uint_as_float(pw.y & 0xffff0000u);
                            d = (f32x4){p0 * fast_sigmoid(d[0] * s), p1 * fast_sigmoid(d[1] * s), p2 * fast_sigmoid(d[2] * s), p3 * fast_sigmoid(d[3] * s)}; }
                        xv = xv + d;
                        if (Yf) *(f32x4*)(Yf + off) = xv;
                        u32x2 w; w.x = cvt_pk_bf16(xv[0], xv[1]); w.y = cvt_pk_bf16(xv[2], xv[3]); *(u32x2*)(XBo + off) = w;
                        ss += (xv[0] * xv[0] + xv[1] * xv[1]) + (xv[2] * xv[2] + xv[3] * xv[3]); }
                ss += __shfl_xor(ss, 16); ss += __shfl_xor(ss, 32);
                if (fq == 0) ssq_out[(size_t)r * 16 + u.pn * 4 + wc] = ss; }
    }
};
template <class Epi, class Sched, bool ALIGN_EPI = false, bool SP2 = false>
__device__ __forceinline__ void gemm_phase(PG8_LAS unsigned char* lds, const Gemm g, const Sched& S, const Epi& E) {
    const int tid = threadIdx.x, wid = __builtin_amdgcn_readfirstlane(tid >> 6), lane = tid & 63, wr = wid >> 2, wc = wid & 3, fr = lane & 15, fq = lane >> 4;
    const int K = g.K, nt = K / BK;
    unsigned voffA[2], voffB[2];
#pragma unroll
    for (int i = 0; i < 2; ++i) { int R, C; stage_rc(tid * 16 + i * 8192, R, C); const int Rb = Epi::PERM ? ((R & ~31) + perm32(R & 31)) : R;
        voffA[i] = (unsigned)(R * K + C) * 2u; voffB[i] = (unsigned)(Rb * K + C) * 2u; }
    const size_t kstep = (size_t)(BK * 2);
    const size_t hstep = (size_t)HALF * K * 2;
    const size_t tstep = 2 * hstep;
    const unsigned ldsw = (unsigned)wid * 1024u;
    const int aoff = lds_byte(wr * 64 + fr, fq * 8), boff = lds_byte(wc * 32 + fr, fq * 8);
#define PG8_SA(b, h) (((b) * 2 + (h)) * HTB)
#define PG8_SB(b, h) ((4 + (b) * 2 + (h)) * HTB)
#define PG8_STAGE(bufoff, gbase, voff) do { _Pragma("unroll") for (int _i = 0; _i < 2; ++_i) \
        __builtin_amdgcn_global_load_lds((const unsigned*)((const char*)(gbase) + (voff)[_i]), (PG8_LAS unsigned*)(lds + (bufoff) + ldsw + _i * 8192), 16, 0, 0); } while (0)
#define PG8_LDA(dst, b, h) do { _Pragma("unroll") for (int m = 0; m < 4; ++m) _Pragma("unroll") for (int k = 0; k < 2; ++k) dst[m][k] = *(const PG8_LAS bf16x8*)(lds + PG8_SA(b, h) + aoff + m * 2048 + k * 1024); } while (0)
#define PG8_LDB(dst, b, h) do { _Pragma("unroll") for (int n = 0; n < 2; ++n) _Pragma("unroll") for (int k = 0; k < 2; ++k) dst[n][k] = *(const PG8_LAS bf16x8*)(lds + PG8_SB(b, h) + boff + n * 2048 + k * 1024); } while (0)
#define PG8_MMA(ai, bj, At, Bt) do { __builtin_amdgcn_s_setprio(1); _Pragma("unroll") for (int m = 0; m < 4; ++m) _Pragma("unroll") for (int n = 0; n < 2; ++n) _Pragma("unroll") for (int k = 0; k < 2; ++k) \
        acc[ai][bj][m][n] = __builtin_amdgcn_mfma_f32_16x16x32_bf16(Bt[n][k], At[m][k], acc[ai][bj][m][n], 0, 0, 0); __builtin_amdgcn_s_setprio(0); } while (0)
#define PG8_WAIT_V(n) asm volatile("s_waitcnt vmcnt(" #n ")" ::: "memory")
#define PG8_WAIT_L(n) asm volatile("s_waitcnt lgkmcnt(" #n ")" ::: "memory")
#define PG8_BAR __builtin_amdgcn_s_barrier()
#define PG8_SCHED __builtin_amdgcn_sched_barrier(0)
    Unit cur, nxt; int ui = 0;
    if (!S.next(0, cur)) return;
    f32x4 acc[2][2][4][2];
#pragma unroll
    for (int a = 0; a < 2; ++a)
#pragma unroll
        for (int b = 0; b < 2; ++b)
#pragma unroll
            for (int m = 0; m < 4; ++m)
#pragma unroll
                for (int n = 0; n < 2; ++n) acc[a][b][m][n] = (f32x4){0.f, 0.f, 0.f, 0.f};
    bf16x8 At[4][2], B0[2][2], B1[2][2];
    const char* cA = (const char*)g.A + (size_t)cur.pm * tstep; const char* cB = (const char*)g.Bt + (size_t)cur.pn * tstep;
    S.a_ready(cur);
    if constexpr (SP2) {
        PG8_STAGE(PG8_SB(0, 0), cB, voffB); PG8_STAGE(PG8_SB(0, 1), cB + hstep, voffB); PG8_STAGE(PG8_SA(0, 0), cA, voffA); PG8_STAGE(PG8_SA(0, 1), cA + hstep, voffA);
        if (wr == 1) PG8_BAR;
        PG8_WAIT_V(2); PG8_BAR;
        PG8_STAGE(PG8_SB(1, 0), cB + kstep, voffB); PG8_STAGE(PG8_SA(1, 0), cA + kstep, voffA); PG8_STAGE(PG8_SB(1, 1), cB + hstep + kstep, voffB);
        PG8_WAIT_V(6); PG8_BAR;
    } else {
        PG8_STAGE(PG8_SB(0, 0), cB, voffB); PG8_STAGE(PG8_SA(0, 0), cA, voffA); PG8_STAGE(PG8_SB(0, 1), cB + hstep, voffB); PG8_STAGE(PG8_SA(0, 1), cA + hstep, voffA);
        if (wr == 1) PG8_BAR;
        PG8_WAIT_V(4); PG8_BAR;
        PG8_STAGE(PG8_SB(1, 0), cB + kstep, voffB); PG8_STAGE(PG8_SA(1, 0), cA + kstep, voffA); PG8_STAGE(PG8_SB(1, 1), cB + hstep + kstep, voffB);
        PG8_WAIT_V(6); PG8_BAR;
    }
    for (;;) {
        const bool has_next = S.next(ui + 1, nxt);
        const char* nA = has_next ? (const char*)g.A + (size_t)nxt.pm * tstep : cA; const char* nB = has_next ? (const char*)g.Bt + (size_t)nxt.pn * tstep : cB;
        for (int t = 0; t < nt; t += 2) {
            const bool last = (t == nt - 2);
            const char* a1 = cA + (size_t)(t + 1) * kstep;
            const char* a2 = last ? nA : cA + (size_t)(t + 2) * kstep; const char* b2 = last ? nB : cB + (size_t)(t + 2) * kstep;
            const char* a3 = a2 + kstep; const char* b3 = b2 + kstep;
            if (last && has_next) S.a_ready(nxt);
            if constexpr (SP2) {
            PG8_LDB(B0, 0, 0); PG8_LDB(B1, 0, 1); PG8_SCHED; PG8_LDA(At, 0, 0); PG8_STAGE(PG8_SA(1, 1), a1 + hstep, voffA);
            PG8_WAIT_V(8); PG8_WAIT_L(0); PG8_BAR; PG8_MMA(0, 0, At, B0); PG8_MMA(0, 1, At, B1); PG8_BAR; PG8_SCHED;
            PG8_LDA(At, 0, 1); PG8_STAGE(PG8_SB(0, 0), b2, voffB); PG8_STAGE(PG8_SB(0, 1), b2 + hstep, voffB); PG8_STAGE(PG8_SA(0, 0), a2, voffA);
            PG8_WAIT_V(8); PG8_WAIT_L(0); PG8_BAR; PG8_MMA(1, 0, At, B0); PG8_MMA(1, 1, At, B1); PG8_BAR; PG8_SCHED;
            PG8_LDB(B0, 1, 0); PG8_LDB(B1, 1, 1); PG8_SCHED; PG8_LDA(At, 1, 0); PG8_STAGE(PG8_SA(0, 1), a2 + hstep, voffA);
            PG8_WAIT_V(8); PG8_WAIT_L(0); PG8_BAR; PG8_MMA(0, 0, At, B0); PG8_MMA(0, 1, At, B1); PG8_BAR; PG8_SCHED;
            PG8_LDA(At, 1, 1); PG8_STAGE(PG8_SB(1, 0), b3, voffB); PG8_STAGE(PG8_SB(1, 1), b3 + hstep, voffB); PG8_STAGE(PG8_SA(1, 0), a3, voffA);
            PG8_WAIT_V(8); PG8_WAIT_L(0); PG8_BAR; PG8_MMA(1, 0, At, B0); PG8_MMA(1, 1, At, B1); PG8_BAR; PG8_SCHED;
            } else {
            PG8_LDB(B0, 0, 0); PG8_SCHED; PG8_LDA(At, 0, 0); PG8_STAGE(PG8_SA(1, 1), a1 + hstep, voffA);
            PG8_WAIT_L(8); PG8_BAR; PG8_WAIT_L(0); PG8_MMA(0, 0, At, B0); PG8_BAR; PG8_SCHED;
            PG8_LDB(B1, 0, 1); PG8_STAGE(PG8_SB(0, 0), b2, voffB);
            PG8_BAR; PG8_WAIT_L(0); PG8_MMA(0, 1, At, B1); PG8_BAR;
            PG8_LDA(At, 0, 1); PG8_STAGE(PG8_SA(0, 0), a2, voffA);
            PG8_BAR; PG8_WAIT_L(0); PG8_MMA(1, 0, At, B0); PG8_BAR; PG8_SCHED;
            PG8_STAGE(PG8_SB(0, 1), b2 + hstep, voffB);
            PG8_WAIT_V(6); PG8_BAR; PG8_MMA(1, 1, At, B1); PG8_BAR;
            PG8_LDB(B0, 1, 0); PG8_SCHED; PG8_LDA(At, 1, 0); PG8_STAGE(PG8_SA(0, 1), a2 + hstep, voffA);
            PG8_WAIT_L(8); PG8_BAR; PG8_WAIT_L(0); PG8_MMA(0, 0, At, B0); PG8_BAR; PG8_SCHED;
            PG8_LDB(B1, 1, 1); PG8_STAGE(PG8_SB(1, 0), b3, voffB);
            PG8_BAR; PG8_WAIT_L(0); PG8_MMA(0, 1, At, B1); PG8_BAR;
            PG8_LDA(At, 1, 1); PG8_STAGE(PG8_SA(1, 0), a3, voffA);
            PG8_BAR; PG8_WAIT_L(0); PG8_MMA(1, 0, At, B0); PG8_BAR; PG8_SCHED;
            PG8_STAGE(PG8_SB(1, 1), b3 + hstep, voffB);
            PG8_WAIT_V(6); PG8_BAR; PG8_MMA(1, 1, At, B1); PG8_BAR;
            }
        }
        if constexpr (ALIGN_EPI) { if (wr == 0) PG8_BAR; }
        if constexpr (!Epi::AFTER_DRAIN) { E(acc, cur, wr, wc, fr, fq); S.done(cur); }
        if (!has_next) break;
#pragma unroll
        for (int a = 0; a < 2; ++a)
#pragma unroll
            for (int b = 0; b < 2; ++b)
#pragma unroll
                for (int m = 0; m < 4; ++m)
#pragma unroll
                    for (int n = 0; n < 2; ++n) acc[a][b][m][n] = (f32x4){0.f, 0.f, 0.f, 0.f};
        cur = nxt; cA = nA; cB = nB; ++ui;
        if constexpr (ALIGN_EPI) { if (wr == 1) PG8_BAR; }
    }
    PG8_WAIT_V(0);
    if constexpr (!ALIGN_EPI) { if (wr == 0) PG8_BAR; }
    PG8_BAR;
    if constexpr (Epi::AFTER_DRAIN) { E.fused(acc, cur, wr, wc, fr, fq, lds, wid, lane); S.done(cur); }
#undef PG8_SA
#undef PG8_SB
#undef PG8_STAGE
#undef PG8_LDA
#undef PG8_LDB
#undef PG8_MMA
#undef PG8_WAIT_V
#undef PG8_WAIT_L
#undef PG8_BAR
#undef PG8_SCHED
}
}
#define LAS __attribute__((address_space(3)))
#define XB_TMO      128
#define XB_XCNT(j)  (256  + 64 * (j))
#define XB_XSUB(j)  (1280 + 64 * (j))
#define XB_XGEN(j)  (2304 + 64 * (j))
#define XB_TOP      3328
#define XB_TOPGEN   3392
#define XCD_BAR_WORDS 3456
#define XB_SPIN_CAP (1u << 18)

__device__ __forceinline__ unsigned xb_ld(unsigned* p)              { return __hip_atomic_load(p, __ATOMIC_RELAXED, __HIP_MEMORY_SCOPE_AGENT); }
__device__ __forceinline__ unsigned xb_add(unsigned* p, unsigned v) { return __hip_atomic_fetch_add(p, v, __ATOMIC_RELAXED, __HIP_MEMORY_SCOPE_AGENT); }
__device__ __forceinline__ unsigned xb_xcc_id() { return (unsigned)__builtin_amdgcn_s_getreg((3 << 11) | 20) & 0xFu; }
#define XB_SPIN(cond, bar) do { unsigned _sp = 0; while (cond) { __builtin_amdgcn_s_sleep(1); \
    if ((++_sp & 255u) == 0u) { if (xb_ld(&(bar)[XB_TMO])) break; if (_sp > XB_SPIN_CAP) { atomicAdd(&(bar)[XB_TMO], 1u); break; } } } } while (0)

struct XcdBarrier {
    unsigned* bar; unsigned x;
    volatile LAS unsigned* st;
};

__device__ __forceinline__ XcdBarrier xcd_barrier_post(unsigned* bar, volatile LAS unsigned* st) {
    XcdBarrier b; b.bar = bar; b.x = xb_xcc_id(); b.st = st;
    if (threadIdx.x == 0) (void)xb_add(&bar[XB_XCNT(b.x)], 1u);
    return b;
}
__device__ __forceinline__ void xcd_barrier_complete(unsigned* bar, unsigned x, unsigned& nloc, unsigned& nx) {
    const unsigned G = gridDim.x * gridDim.y * gridDim.z;
    unsigned sum, cnt, mine, sp = 0u;
    for (;;) {
        sum = 0u; cnt = 0u; mine = 0u;
#pragma unroll
        for (unsigned j = 0; j < 16; ++j) { const unsigned c = xb_ld(&bar[XB_XCNT(j)]); sum += c; cnt += (c > 0u) ? 1u : 0u; mine = (j == x) ? c : mine; }
        if (sum == G) break;
        __builtin_amdgcn_s_sleep(1);
        if ((++sp & 255u) == 0u) { if (xb_ld(&bar[XB_TMO])) break; if (sp > XB_SPIN_CAP) { atomicAdd(&bar[XB_TMO], 1u); break; } }
    }
    nloc = mine > 0u ? mine : 1u; nx = cnt > 0u ? cnt : 1u;
}

__device__ __forceinline__ void xcd_barrier(const XcdBarrier& b) {
    asm volatile("s_waitcnt vmcnt(0)" ::: "memory");
    __syncthreads();
    if (threadIdx.x == 0) {
        unsigned* bar = b.bar;
        __builtin_amdgcn_s_waitcnt(0);
        unsigned nloc = b.st[0], nx = b.st[1];
        if (nloc == 0u) { xcd_barrier_complete(bar, b.x, nloc, nx); b.st[0] = nloc; b.st[1] = nx; }
        const unsigned old = xb_add(&bar[XB_XSUB(b.x)], 1u);
        const unsigned gen = old / nloc;
        if (old + 1u == (gen + 1u) * nloc) {
            __builtin_amdgcn_fence(__ATOMIC_RELEASE, "agent");
            asm volatile("s_waitcnt vmcnt(0)" ::: "memory");
            const unsigned og = xb_add(&bar[XB_TOP], 1u);
            const unsigned tg = og / nx;
            if (og + 1u == (tg + 1u) * nx) xb_add(&bar[XB_TOPGEN], 1u);
            else XB_SPIN(xb_ld(&bar[XB_TOPGEN]) == tg, bar);
            __builtin_amdgcn_fence(__ATOMIC_ACQUIRE, "agent");
            xb_add(&bar[XB_XGEN(b.x)], 1u);
            asm volatile("s_waitcnt vmcnt(0)" ::: "memory");
        } else {
            XB_SPIN(xb_ld(&bar[XB_XGEN(b.x)]) == gen, bar);
            __builtin_amdgcn_fence(__ATOMIC_ACQUIRE, "agent");
            asm volatile("s_waitcnt vmcnt(0)" ::: "memory");
        }
    }
    __syncthreads();
}
#undef LAS
namespace mk {
using pg8::bf16_t;
typedef float f32x4 __attribute__((ext_vector_type(4)));
typedef unsigned u32x4 __attribute__((ext_vector_type(4)));
typedef unsigned u32x2 __attribute__((ext_vector_type(2)));
constexpr int NWAVES = 8;
constexpr int D = 1024, SEQ = 2048, NBP = 8, NBS = 128, TS = 4, PAST = 2048;
constexpr int MP = NBP * SEQ, MS = NBS * TS, MT = MP + MS;
constexpr int GIN = 3088, NPROJ = 3072, FF = 2816, PLE = 256;
constexpr float EPS = 1e-6f;
constexpr size_t OUT_Y = 0, OUT_GSP = 17301504, OUT_GSS = 19398656, OUT_KP = 52953088, OUT_VP = 61341696, OUT_KS = 69730304, OUT_VS = 69992448;
constexpr size_t MiB = 1u << 20;
constexpr size_t al(size_t x) { return (x + 255) & ~(size_t)255; }
constexpr size_t WS_CTL = 0, CTL_BYTES = 2 * MiB;
constexpr int CW_BAR = 4096;
constexpr size_t WS_SSQ = 1 * MiB;
constexpr size_t WS_WIN = 2 * MiB;
constexpr size_t WS_WGLR = al(WS_WIN + 2ull * 3072 * 1024 * 2);
constexpr size_t WS_WAO = al(WS_WGLR + 2ull * 16 * 1024 * 4);
constexpr size_t WS_WQKV = al(WS_WAO + 2ull * 1024 * 1024 * 2);
constexpr size_t WS_WQ1 = al(WS_WQKV + 4096ull * 1024 * 2);
constexpr size_t WS_WBO = al(WS_WQ1 + 3072ull * 1024 * 2);
constexpr size_t WS_WFIN = al(WS_WBO + 2ull * 1024 * 1024 * 2);
constexpr size_t WS_WFOUT = al(WS_WFIN + 4ull * 5632 * 1024 * 2);
constexpr size_t WS_WPROJ = al(WS_WFOUT + 4ull * 1024 * 2816 * 2);
constexpr size_t WS_WGATE = al(WS_WPROJ + 4ull * 1024 * 256 * 2);
constexpr size_t WS_XB = al(WS_WGATE + 4ull * 1024 * 1024 * 2);
constexpr size_t WS_PROJ = al(WS_XB + 3ull * MT * 1024 * 2);
constexpr size_t WS_H = al(WS_PROJ + (size_t)MT * 3072 * 2);
constexpr size_t WS_ON = al(WS_H + (size_t)MT * 2816 * 2);
constexpr size_t WS_PP = al(WS_ON + (size_t)MT * 1024 * 2);
constexpr size_t WS_PB = al(WS_PP + 4ull * MT * 1024 * 2);
constexpr size_t WS_GLR = al(WS_PB + 4ull * MT * 256 * 2);
constexpr size_t WS_KVRAW = al(WS_GLR + (size_t)MT * 16 * 4);
constexpr size_t WS_KB = al(WS_KVRAW + (size_t)MT * 1024 * 4);
constexpr size_t WS_VB = al(WS_KB + (size_t)MT * 512 * 2);
constexpr size_t WS_VT = al(WS_VB + (size_t)MT * 512 * 2);
constexpr size_t WS_OG = al(WS_VT + 3ull * MP * 512 * 2);
constexpr size_t WS_LSE = al(WS_OG + 2ull * MP * 1024 * 2);
constexpr size_t WS_ROPE = al(WS_LSE + 2ull * MP * 8 * 4);
constexpr size_t WS_QIG = al(WS_ROPE + 2052ull * 16 * 2 * 4);
constexpr size_t WS_KETG = al(WS_QIG + (size_t)MP * 512 * 2);
constexpr size_t WS_VTG = al(WS_KETG + (size_t)MP * 512 * 2);
constexpr size_t WS_DECG = al(WS_VTG + (size_t)MP * 1024 * 2);
constexpr size_t WS_SSQM = al(WS_DECG + 1024ull * 128 * 4);
constexpr size_t WS_ATTG = al(WS_SSQM + 13ull * MP * 16 * 4);
constexpr size_t WS_CK = al(WS_ATTG + 1024ull * 64 * 64 * 2);
constexpr size_t WS_CV = al(WS_CK + 128ull * 4 * 900 * 128 * 2);
constexpr size_t WS_END = al(WS_CV + 128ull * 4 * 900 * 128 * 2);
constexpr int RING_BYTES = 139264, LDSCTL_OFF = RING_BYTES, MISC_OFF = LDSCTL_OFF + 320, LDS_BYTES = 147456;

#define LAS __attribute__((address_space(3)))
__device__ __forceinline__ float bf2f(bf16_t b) { return __uint_as_float(((unsigned)b) << 16); }
__device__ __forceinline__ float bflo(unsigned w) { return __uint_as_float(w << 16); }
__device__ __forceinline__ float bfhi(unsigned w) { return __uint_as_float(w & 0xffff0000u); }
__device__ __forceinline__ unsigned pk2(float lo, float hi) { return pg8::cvt_pk_bf16(lo, hi); }
__device__ __forceinline__ float wave_sum(float v) {
#pragma unroll
    for (int o = 1; o < 64; o <<= 1) v += __shfl_xor(v, o);
    return v;
}
__device__ __forceinline__ float wave_max(float v) {
#pragma unroll
    for (int o = 1; o < 64; o <<= 1) v = fmaxf(v, __shfl_xor(v, o));
    return v;
}
#define LDS_WAIT() asm volatile("s_waitcnt lgkmcnt(0)" ::: "memory")
#define LDS_BARRIER() do { asm volatile("s_waitcnt lgkmcnt(0)" ::: "memory"); __builtin_amdgcn_s_barrier(); asm volatile("" ::: "memory"); } while (0)

struct Args { const float* in[26]; float* out; unsigned char* ws; int ph_lo, ph_hi, use_bar, pad; };

struct Frame {
    LAS unsigned char* lds; int tid, lane, wave, vcu, G;
};

struct MatDesc { const float* W; int ldw, K, Nd, kind; bf16_t* WT; const float* gain; };
__device__ __forceinline__ void get_mat(const Args& A, int mi, MatDesc& m) {
    unsigned char* ws = A.ws;
    if (mi < 2) { const int l = mi; m = MatDesc{A.in[8] + (size_t)l * 1024 * GIN, GIN, 1024, 3072, 1, (bf16_t*)(ws + WS_WIN) + (size_t)l * 3072 * 1024, A.in[7] + l * 1024}; return; }
    if (mi < 4) { const int l = mi - 2; m = MatDesc{A.in[12] + (size_t)l * 1024 * 1024, 1024, 1024, 1024, 0, (bf16_t*)(ws + WS_WAO) + (size_t)l * 1024 * 1024, nullptr}; return; }
    if (mi == 4) { m = MatDesc{A.in[17], 3072, 1024, 3072, 0, (bf16_t*)(ws + WS_WQKV), A.in[16]}; return; }
    if (mi == 5) { m = MatDesc{A.in[14], 1024, 1024, 1024, 0, (bf16_t*)(ws + WS_WQKV) + (size_t)3072 * 1024, A.in[13]}; return; }
    if (mi == 6) { m = MatDesc{A.in[17] + (size_t)1024 * 3072, 3072, 1024, 3072, 0, (bf16_t*)(ws + WS_WQ1), A.in[16] + 1024}; return; }
    if (mi < 9) { const int j = mi - 7; m = MatDesc{A.in[19] + (size_t)j * 1024 * 1024, 1024, 1024, 1024, 0, (bf16_t*)(ws + WS_WBO) + (size_t)j * 1024 * 1024, nullptr}; return; }
    if (mi < 13) { const int i = mi - 9; m = MatDesc{A.in[21] + (size_t)i * 1024 * 5632, 5632, 1024, 5632, 2, (bf16_t*)(ws + WS_WFIN) + (size_t)i * 5632 * 1024, A.in[20] + i * 1024}; return; }
    if (mi < 17) { const int i = mi - 13; m = MatDesc{A.in[22] + (size_t)i * 2816 * 1024, 1024, 2816, 1024, 0, (bf16_t*)(ws + WS_WFOUT) + (size_t)i * 1024 * 2816, nullptr}; return; }
    if (mi < 21) { const int i = mi - 17; m = MatDesc{A.in[24] + (size_t)i * 256 * 1024, 1024, 256, 1024, 0, (bf16_t*)(ws + WS_WPROJ) + (size_t)i * 1024 * 256, nullptr}; return; }
    { const int i = mi - 21; m = MatDesc{A.in[25] + (size_t)i * 1024 * 1024, 1024, 1024, 1024, 0, (bf16_t*)(ws + WS_WGATE) + (size_t)i * 1024 * 1024, A.in[23] + i * 1024}; }
}
constexpr int NMAT = 25;
__device__ __forceinline__ void transpose_item(const MatDesc& m, int item, LAS float* scr, int lane) {
    const int nblk = m.Nd >> 6, kb = item / nblk, nb = item - kb * nblk, k0 = 64 * kb, n0 = 64 * nb;
    int src0 = n0; float scale = 1.0f;
    if (m.kind == 1) { if (n0 < 512) scale = 0.08838834764831845f; }
    if (m.kind == 2) { const int pn = n0 >> 8, half = (n0 >> 7) & 1, i0 = n0 & 127; src0 = half * FF + 128 * pn + i0; }
    const int kq = lane >> 4, n4 = lane & 15;
    f32x4 v[16]; float g[16];
#pragma unroll
    for (int i = 0; i < 16; ++i) { v[i] = __builtin_nontemporal_load((const f32x4*)(m.W + (size_t)(k0 + 4 * i + kq) * m.ldw + src0 + 4 * n4)); g[i] = m.gain ? m.gain[k0 + 4 * i + kq] * scale : scale; }
#pragma unroll
    for (int i = 0; i < 16; ++i) { LAS float* d = scr + (4 * i + kq) * 65 + 4 * n4; d[0] = v[i][0] * g[i]; d[1] = v[i][1] * g[i]; d[2] = v[i][2] * g[i]; d[3] = v[i][3] * g[i]; }
    LDS_WAIT();
    const int c = lane & 7;
#pragma unroll
    for (int j = 0; j < 8; ++j) { const int n = (lane >> 3) + 8 * j; const LAS float* sp = scr + (8 * c) * 65 + n;
        u32x4 o; o.x = pk2(sp[0 * 65], sp[1 * 65]); o.y = pk2(sp[2 * 65], sp[3 * 65]); o.z = pk2(sp[4 * 65], sp[5 * 65]); o.w = pk2(sp[6 * 65], sp[7 * 65]);
        *(u32x4*)(m.WT + (size_t)(n0 + n) * m.K + k0 + 8 * c) = o; }
    LDS_WAIT();
}
__device__ __forceinline__ void p0_prologue(const Args& A, Frame& F) {
    LAS float* scr = (LAS float*)(F.lds + F.wave * 17408);
    const int gw = F.vcu * NWAVES + F.wave, NGW = F.G * NWAVES, lane = F.lane;
    {
        int base = 0;
        for (int mi = 0; mi < NMAT; ++mi) {
            MatDesc m; get_mat(A, mi, m);
            const int cnt = (m.K >> 6) * (m.Nd >> 6);
            int it = gw - (base % NGW); if (it < 0) it += NGW;
            for (; it < cnt; it += NGW) transpose_item(m, it, scr, lane);
            base += cnt;
        }
    }
    {
        bf16_t* wg = (bf16_t*)(A.ws + WS_WGLR);
        for (int e = (gw * 64 + lane); e < 2 * 16 * 1024; e += NGW * 64) { const int l = e >> 14, j = (e >> 10) & 15, k = e & 1023;
            wg[e] = (bf16_t)(pk2(A.in[7][l * 1024 + k] * A.in[8][((size_t)l * 1024 + k) * GIN + 3072 + j], 0.f) & 0xffffu); }
    }
    {
        float* rt = (float*)(A.ws + WS_ROPE);
        for (int e = gw * 64 + lane; e < 2052 * 16; e += NGW * 64) { const int pos = e >> 4, i = e & 15; float sn, cs; sincosf((float)pos * powf(500000.0f, -(float)i * (1.0f / 16.0f)), &sn, &cs);
            rt[2 * e] = cs; rt[2 * e + 1] = sn; }
    }
    {
        bf16_t* xb = (bf16_t*)(A.ws + WS_XB); float* ssq = (float*)(A.ws + WS_SSQ);
        for (int r0 = 2 * gw; r0 < MT; r0 += 2 * NGW) {
            f32x4 v[2][4];
#pragma unroll
            for (int q = 0; q < 2; ++q) { const int r = r0 + q; const float* src = r < MP ? A.in[0] + (size_t)r * D : A.in[1] + (size_t)(r - MP) * D;
#pragma unroll
                for (int j = 0; j < 4; ++j) v[q][j] = __builtin_nontemporal_load((const f32x4*)(src + 256 * j + 4 * lane)); }
#pragma unroll
            for (int q = 0; q < 2; ++q) { const int r = r0 + q; float ss = 0.f;
#pragma unroll
                for (int j = 0; j < 4; ++j) { const f32x4 w4 = v[q][j];
                    u32x2 w; w.x = pk2(w4[0], w4[1]); w.y = pk2(w4[2], w4[3]); *(u32x2*)(xb + (size_t)r * D + 256 * j + 4 * lane) = w;
                    ss += (w4[0] * w4[0] + w4[1] * w4[1]) + (w4[2] * w4[2] + w4[3] * w4[3]); }
                ss = wave_sum(ss); float* sp = r < MP ? (float*)(A.ws + WS_SSQM) + (size_t)r * 16 : ssq + (size_t)(r - MP) * 16; if (lane < 16) sp[lane] = lane == 0 ? ss : 0.f; }
        }
    }
    {
        bf16_t* pb = (bf16_t*)(A.ws + WS_PB);
        for (int e0 = 11 * gw; e0 < 4 * MT; e0 += 11 * NGW) {
            f32x4 v[11];
#pragma unroll
            for (int q = 0; q < 11; ++q) { const int e = e0 + q, l = e / MT, r = e - l * MT;
                const float* src = r < MP ? A.in[2] + ((size_t)l * MP + r) * PLE : A.in[3] + ((size_t)l * MS + (r - MP)) * PLE; v[q] = __builtin_nontemporal_load((const f32x4*)(src + 4 * lane)); }
#pragma unroll
            for (int q = 0; q < 11; ++q) { const int e = e0 + q, l = e / MT, r = e - l * MT; u32x2 w; w.x = pk2(v[q][0], v[q][1]); w.y = pk2(v[q][2], v[q][3]);
                *(u32x2*)(pb + ((size_t)l * MT + r) * PLE + 4 * lane) = w; }
        }
    }
}

__device__ __forceinline__ void glr_rows(const Args& A, Frame& F, int l, const bf16_t* xb, const float* ssq, const float* ssqs) {
    typedef short gbf16x8 __attribute__((ext_vector_type(8)));
    const int gw = F.vcu * NWAVES + F.wave, NGW = F.G * NWAVES, lane = F.lane, i16 = lane & 15, q = lane >> 4;
    const bf16_t* wg = (const bf16_t*)(A.ws + WS_WGLR) + (size_t)l * 16 * 1024 + (size_t)i16 * 1024 + 8 * q;
    float* glr = (float*)(A.ws + WS_GLR);
    for (int tile = gw; tile < MT / 16; tile += NGW) {
        const int row0 = 16 * tile; const bf16_t* ap = xb + (size_t)(row0 + i16) * D + 8 * q;
        f32x4 acc = (f32x4){0.f, 0.f, 0.f, 0.f};
#pragma unroll
        for (int h2 = 0; h2 < 2; ++h2) {
            gbf16x8 a[16], b[16];
#pragma unroll
            for (int ks = 0; ks < 16; ++ks) { a[ks] = *(const gbf16x8*)(ap + 32 * (16 * h2 + ks)); b[ks] = *(const gbf16x8*)(wg + 32 * (16 * h2 + ks)); }
#pragma unroll
            for (int ks = 0; ks < 16; ++ks) acc = __builtin_amdgcn_mfma_f32_16x16x32_bf16(a[ks], b[ks], acc, 0, 0, 0);
        }
#pragma unroll
        for (int rg = 0; rg < 4; ++rg) { const int row = row0 + 4 * q + rg; glr[(size_t)row * 16 + i16] = acc[rg] * (row < MP ? pg8::rstd_of(ssq, row) : pg8::rstd_of(ssqs, row - MP)); }
    }
}

__device__ __forceinline__ void gla_naive_item(const Args& A, Frame& F, int l, int item) {
    const bool samp = item < 512; const int idx = samp ? item : item - 512; const int b = idx >> 2, h = idx & 3;
    const int row0 = samp ? MP + TS * b : b * SEQ; const int T = samp ? TS : SEQ;
    const int tid = F.tid, dv = tid & 255, half = tid >> 8, lane = F.lane;
    LAS float* aL = (LAS float*)(F.lds); LAS float* kL = aL + 1024; LAS float* qL = kL + 1024; LAS float* oL = qL + 1024;
    const bf16_t* proj = (const bf16_t*)(A.ws + WS_PROJ); const float* glr = (const float*)(A.ws + WS_GLR);
    const float* wup = A.in[9] + (size_t)l * 16 * 512 + h * 128; const float* bgk = A.in[10] + l * 512 + h * 128; const float* onorm = A.in[11] + l * 256;
    bf16_t* on = (bf16_t*)(A.ws + WS_ON);
    float S[64];
    if (samp) { const float* s0 = A.in[4] + ((((size_t)l * NBS + b) * 4 + h) * 128 + 64 * half) * 256 + dv;
#pragma unroll
        for (int i = 0; i < 64; ++i) S[i] = __builtin_nontemporal_load(s0 + (size_t)i * 256); }
    else {
#pragma unroll
        for (int i = 0; i < 64; ++i) S[i] = 0.f; }
    for (int t0 = 0; t0 < T; t0 += 8) {
        const int tb = (T - t0) < 8 ? (T - t0) : 8;
        for (int e = tid; e < tb * 128; e += 512) { const int tt = e >> 7, dk = e & 127; const size_t row = (size_t)(row0 + t0 + tt);
            float z = bgk[dk];
#pragma unroll
            for (int j = 0; j < 16; ++j) z += glr[row * 16 + j] * wup[j * 512 + dk];
            const float ls = fminf(z, 0.f) - log1pf(expf(-fabsf(z)));
            aL[e] = expf(ls * (1.0f / 16.0f));
            kL[e] = bf2f(proj[row * NPROJ + 512 + h * 128 + dk]); qL[e] = bf2f(proj[row * NPROJ + h * 128 + dk]); }
        __syncthreads();
        float vv[8];
#pragma unroll
        for (int tt = 0; tt < 8; ++tt) vv[tt] = tt < tb ? bf2f(proj[(size_t)(row0 + t0 + tt) * NPROJ + 1024 + h * 256 + dv]) : 0.f;
#pragma unroll
        for (int tt = 0; tt < 8; ++tt) {
            if (tt < tb) { const LAS float* a = aL + tt * 128 + 64 * half; const LAS float* k = kL + tt * 128 + 64 * half; const LAS float* q = qL + tt * 128 + 64 * half; float o = 0.f; const float v = vv[tt];
#pragma unroll
                for (int i = 0; i < 64; ++i) { S[i] = a[i] * S[i] + k[i] * v; o += q[i] * S[i]; }
                oL[(half * 8 + tt) * 256 + dv] = o; }
        }
        __syncthreads();
        { const int tt = F.wave;
          if (tt < tb) { const size_t row = (size_t)(row0 + t0 + tt);
              const f32x4 o0 = *(const LAS f32x4*)(oL + (0 * 8 + tt) * 256 + 4 * lane), o1 = *(const LAS f32x4*)(oL + (1 * 8 + tt) * 256 + 4 * lane); const f32x4 o = o0 + o1;
              const float ss = wave_sum((o[0] * o[0] + o[1] * o[1]) + (o[2] * o[2] + o[3] * o[3])); const float rs = __builtin_amdgcn_rsqf(ss * (1.0f / 256.0f) + EPS);
              const u32x2 rw = *(const u32x2*)(proj + row * NPROJ + 2048 + h * 256 + 4 * lane); const f32x4 g = *(const f32x4*)(onorm + 4 * lane);
              const float r0 = bflo(rw.x), r1 = bfhi(rw.x), r2 = bflo(rw.y), r3 = bfhi(rw.y);
              u32x2 w; w.x = pk2(o[0] * rs * g[0] * r0 * pg8::fast_sigmoid(r0), o[1] * rs * g[1] * r1 * pg8::fast_sigmoid(r1));
              w.y = pk2(o[2] * rs * g[2] * r2 * pg8::fast_sigmoid(r2), o[3] * rs * g[3] * r3 * pg8::fast_sigmoid(r3));
              *(u32x2*)(on + row * D + h * 256 + 4 * lane) = w; } }
        __syncthreads();
    }
    float* so = (samp ? A.out + OUT_GSS + (((size_t)l * NBS + b) * 4 + h) * 128 * 256 : A.out + OUT_GSP + (((size_t)l * NBP + b) * 4 + h) * 128 * 256) + (size_t)(64 * half) * 256 + dv;
#pragma unroll
    for (int i = 0; i < 64; ++i) __builtin_nontemporal_store(S[i], so + (size_t)i * 256);
}

__device__ __forceinline__ float rope_freq(int i) { return powf(500000.0f, -(float)i * (1.0f / 16.0f)); }
__device__ __forceinline__ void kn_rows(const Args& A, Frame& F) {
    const int gw = F.vcu * NWAVES + F.wave, NGW = F.G * NWAVES, lane = F.lane;
    const float* kv = (const float*)(A.ws + WS_KVRAW); bf16_t* kb = (bf16_t*)(A.ws + WS_KB); bf16_t* vb = (bf16_t*)(A.ws + WS_VB);
    const float* kn = A.in[15];
    const int d0 = (lane & 15) * 8;
    for (int r = gw; r < MT; r += NGW) {
        const bool samp = r >= MP; const int ipos = samp ? (PAST + ((r - MP) & 3)) : (r & (SEQ - 1));
        float* ko = samp ? A.out + OUT_KS + (size_t)(r - MP) * 512 : A.out + OUT_KP + (size_t)r * 512;
        float* vo = samp ? A.out + OUT_VS + (size_t)(r - MP) * 512 : A.out + OUT_VP + (size_t)r * 512;
        const f32x4 k0 = *(const f32x4*)(kv + (size_t)r * 1024 + 8 * lane), k1 = *(const f32x4*)(kv + (size_t)r * 1024 + 8 * lane + 4);
        const f32x4 v0 = *(const f32x4*)(kv + (size_t)r * 1024 + 512 + 8 * lane), v1 = *(const f32x4*)(kv + (size_t)r * 1024 + 512 + 8 * lane + 4);
        float x[8] = {k0[0], k0[1], k0[2], k0[3], k1[0], k1[1], k1[2], k1[3]};
        float ss = 0.f;
#pragma unroll
        for (int j = 0; j < 8; ++j) ss += x[j] * x[j];
        ss += __shfl_xor(ss, 1); ss += __shfl_xor(ss, 2); ss += __shfl_xor(ss, 4); ss += __shfl_xor(ss, 8);
        const float rs = __builtin_amdgcn_rsqf(ss * (1.0f / 128.0f) + EPS);
#pragma unroll
        for (int j = 0; j < 8; ++j) x[j] = x[j] * rs * kn[d0 + j];
        float y[8];
#pragma unroll
        for (int j = 0; j < 8; ++j) y[j] = __shfl_xor(x[j], 2);
        const int lq = lane & 15;
        if (lq < 4) {
#pragma unroll
            for (int j = 0; j < 8; ++j) { const int fi = (d0 + j) & 15; const float* rt = (const float*)(A.ws + WS_ROPE) + ((size_t)ipos * 16 + fi) * 2; const float cs = rt[0], sn = rt[1];
                x[j] = (lq < 2) ? (x[j] * cs - y[j] * sn) : (x[j] * cs + y[j] * sn); }
        }
        *(f32x4*)(ko + 8 * lane) = (f32x4){x[0], x[1], x[2], x[3]}; *(f32x4*)(ko + 8 * lane + 4) = (f32x4){x[4], x[5], x[6], x[7]};
        *(f32x4*)(vo + 8 * lane) = v0; *(f32x4*)(vo + 8 * lane + 4) = v1;
        u32x4 kw; kw.x = pk2(x[0], x[1]); kw.y = pk2(x[2], x[3]); kw.z = pk2(x[4], x[5]); kw.w = pk2(x[6], x[7]); *(u32x4*)(kb + (size_t)r * 512 + 8 * lane) = kw;
        u32x4 vw; vw.x = pk2(v0[0], v0[1]); vw.y = pk2(v0[2], v0[3]); vw.z = pk2(v1[0], v1[1]); vw.w = pk2(v1[2], v1[3]); *(u32x4*)(vb + (size_t)r * 512 + 8 * lane) = vw;
        if (samp) { const int bs = (r - MP) >> 2, ts = (r - MP) & 3; const size_t o = (((size_t)bs * 4 + (lane >> 4)) * 900 + 896 + ts) * 128 + d0;
            *(u32x4*)((bf16_t*)(A.ws + WS_CK) + o) = kw; *(u32x4*)((bf16_t*)(A.ws + WS_CV) + o) = vw; }
    }
}


__device__ __forceinline__ void cache_compact(const Args& A, Frame& F, int which, int w0, int nw) {
    const int lane = F.lane; const float* src = which ? A.in[6] : A.in[5]; bf16_t* dst = (bf16_t*)(A.ws + (which ? WS_CV : WS_CK));
    const int kvh = lane >> 4, d0 = (lane & 15) * 8;
#pragma unroll 4
    for (int e = w0; e < NBS * 896; e += nw) { const int b = e / 896, slot = e - b * 896;
        const int idx = slot < 512 ? 1536 + slot : (((slot - 512) >> 2) << 4) + ((slot - 512) & 3);
        const float* p = src + (((size_t)b * PAST + idx) * 4 + kvh) * 128 + d0;
        const f32x4 a = __builtin_nontemporal_load((const f32x4*)p), c = __builtin_nontemporal_load((const f32x4*)(p + 4));
        u32x4 w; w.x = pk2(a[0], a[1]); w.y = pk2(a[2], a[3]); w.z = pk2(c[0], c[1]); w.w = pk2(c[2], c[3]);
        *(u32x4*)(dst + (((size_t)b * 4 + kvh) * 900 + slot) * 128 + d0) = w; }
}
typedef short bf16x8 __attribute__((ext_vector_type(8)));
typedef float f32x16 __attribute__((ext_vector_type(16)));
constexpr int ATT_KS = 0, ATT_KSTR = 272, ATT_VS = 69632, ATT_VSTR = 528;
__device__ __forceinline__ unsigned pkc(float a, float b) { __hip_bfloat162 v = __float22bfloat162_rn(make_float2(a, b)); unsigned u; __builtin_memcpy(&u, &v, 4); return u; }
__device__ __forceinline__ bf16x8 pack8(float a0, float a1, float a2, float a3, float a4, float a5, float a6, float a7) {
    u32x4 p; p.x = pkc(a0, a1); p.y = pkc(a2, a3); p.z = pkc(a4, a5); p.w = pkc(a6, a7); return __builtin_bit_cast(bf16x8, p); }
#define MFMA32(a, b, c) __builtin_amdgcn_mfma_f32_32x32x16_bf16((a), (b), (c), 0, 0, 0)

template <bool LAST> __device__ __forceinline__ void att_unit(const Args& A, Frame& F, int j, int un) {
    const int lane = F.lane, r = lane & 31, h = lane >> 5, wv = F.wave, hq = wv >> 2, sb = wv & 3, tid = F.tid;
    const int g = un >> 9, rem = un & 511, bk = rem >> 4, w16 = rem & 15, b = bk >> 2, kvh = bk & 3;
    const int dsh = 2 * g, dil = 1 << dsh, nblk = 16 >> dsh, c = w16 / nblk, jb = w16 - c * nblk;
    const int kb_lo = jb == 0 ? 128 : 0;
    const bf16_t* kbp = (const bf16_t*)(A.ws + WS_KB);
    const bf16_t* vt = (const bf16_t*)(A.ws + WS_VT) + (size_t)g * ((size_t)MP * 512);
    const int ulen = SEQ >> dsh;
    {
        u32x4 kreg[8], vreg[8];
#pragma unroll
        for (int i = 0; i < 8; ++i) { const int e = tid + 512 * i, row = e >> 4, pc = e & 15;
            if (row >= kb_lo) { const int u = jb * 128 - 128 + row, pos = (u << dsh) + c; kreg[i] = *(const u32x4*)(kbp + ((size_t)(b * SEQ + pos)) * 512 + kvh * 128 + pc * 8); } }
#pragma unroll
        for (int i = 0; i < 8; ++i) { const int e = tid + 512 * i, d = e >> 5, pc = e & 31;
            if (pc * 8 >= kb_lo) vreg[i] = *(const u32x4*)(vt + ((size_t)((bk * dil + c) * 128 + d)) * ulen + (jb * 128 - 128) + pc * 8); }
#pragma unroll
        for (int i = 0; i < 8; ++i) { const int e = tid + 512 * i, row = e >> 4, pc = e & 15;
            if (row >= kb_lo) *(LAS u32x4*)(F.lds + ATT_KS + row * ATT_KSTR + pc * 16) = kreg[i]; }
#pragma unroll
        for (int i = 0; i < 8; ++i) { const int e = tid + 512 * i, d = e >> 5, pc = e & 31;
            if (pc * 8 >= kb_lo) *(LAS u32x4*)(F.lds + ATT_VS + d * ATT_VSTR + pc * 16) = vreg[i]; }
    }
    const int qi = jb * 128 + 32 * sb + r, qpos = (qi << dsh) + c; const size_t qrow = (size_t)(b * SEQ + qpos);
    const int slot = kvh * 2 + hq;
    bf16x8 qf[8];
    {
        const bf16_t* qsrc = (const bf16_t*)(A.ws + WS_PROJ) + qrow * NPROJ + g * 1024 + slot * 128 + 8 * h;
        const float* qn = A.in[18] + j * 128 + 8 * h;
        u32x4 qraw[8];
#pragma unroll
        for (int s = 0; s < 8; ++s) qraw[s] = *(const u32x4*)(qsrc + 16 * s);
        float ss = 0.f;
#pragma unroll
        for (int s = 0; s < 8; ++s) { const u32x4 w = qraw[s]; ss += (bflo(w.x) * bflo(w.x) + bfhi(w.x) * bfhi(w.x)) + (bflo(w.y) * bflo(w.y) + bfhi(w.y) * bfhi(w.y)) + (bflo(w.z) * bflo(w.z) + bfhi(w.z) * bfhi(w.z)) + (bflo(w.w) * bflo(w.w) + bfhi(w.w) * bfhi(w.w)); }
        ss += __shfl_xor(ss, 32);
        const float rs = (__builtin_amdgcn_rsqf(ss * (1.0f / 128.0f) + EPS)) * (0.08838834764831845f * 1.4426950408889634f);
        float x1[8], x2[8];
        { const u32x4 w0 = qraw[0], w1 = qraw[1]; const f32x4 ga = *(const f32x4*)(qn), gb = *(const f32x4*)(qn + 4), gc = *(const f32x4*)(qn + 16), gd = *(const f32x4*)(qn + 20);
          x1[0] = bflo(w0.x) * ga[0]; x1[1] = bfhi(w0.x) * ga[1]; x1[2] = bflo(w0.y) * ga[2]; x1[3] = bfhi(w0.y) * ga[3]; x1[4] = bflo(w0.z) * gb[0]; x1[5] = bfhi(w0.z) * gb[1]; x1[6] = bflo(w0.w) * gb[2]; x1[7] = bfhi(w0.w) * gb[3];
          x2[0] = bflo(w1.x) * gc[0]; x2[1] = bfhi(w1.x) * gc[1]; x2[2] = bflo(w1.y) * gc[2]; x2[3] = bfhi(w1.y) * gc[3]; x2[4] = bflo(w1.z) * gd[0]; x2[5] = bfhi(w1.z) * gd[1]; x2[6] = bflo(w1.w) * gd[2]; x2[7] = bfhi(w1.w) * gd[3]; }
        const float* rp = (const float*)(A.ws + WS_ROPE) + ((size_t)qpos * 16 + 8 * h) * 2;
        float y1[8], y2[8];
#pragma unroll
        for (int q4 = 0; q4 < 4; ++q4) { const f32x4 cs = *(const f32x4*)(rp + 4 * q4);
            y1[2 * q4] = (x1[2 * q4] * cs[0] - x2[2 * q4] * cs[1]) * rs; y2[2 * q4] = (x2[2 * q4] * cs[0] + x1[2 * q4] * cs[1]) * rs;
            y1[2 * q4 + 1] = (x1[2 * q4 + 1] * cs[2] - x2[2 * q4 + 1] * cs[3]) * rs; y2[2 * q4 + 1] = (x2[2 * q4 + 1] * cs[2] + x1[2 * q4 + 1] * cs[3]) * rs; }
        qf[0] = pack8(y1[0], y1[1], y1[2], y1[3], y1[4], y1[5], y1[6], y1[7]);
        qf[1] = pack8(y2[0], y2[1], y2[2], y2[3], y2[4], y2[5], y2[6], y2[7]);
#pragma unroll
        for (int s = 2; s < 8; ++s) { const u32x4 w = qraw[s]; const f32x4 ga = *(const f32x4*)(qn + 16 * s), gb = *(const f32x4*)(qn + 16 * s + 4);
            qf[s] = pack8(bflo(w.x) * ga[0] * rs, bfhi(w.x) * ga[1] * rs, bflo(w.y) * ga[2] * rs, bfhi(w.y) * ga[3] * rs, bflo(w.z) * gb[0] * rs, bfhi(w.z) * gb[1] * rs, bflo(w.w) * gb[2] * rs, bfhi(w.w) * gb[3] * rs); }
    }
    LDS_BARRIER();
    const int kt_lo = (jb == 0) ? (4 - sb) : 0;
    f32x16 S[5];
#pragma unroll
    for (int kt = 0; kt < 5; ++kt) {
#pragma unroll
        for (int i = 0; i < 16; ++i) S[kt][i] = 0.f;
        if (kt >= kt_lo) { const LAS unsigned char* kp = F.lds + ATT_KS + (32 * (sb + kt) + r) * ATT_KSTR + 16 * h;
#pragma unroll
            for (int s = 0; s < 8; ++s) { const bf16x8 kf = *(const LAS bf16x8*)(kp + 32 * s); S[kt] = MFMA32(kf, qf[s], S[kt]); } }
    }
#pragma unroll
    for (int i = 0; i < 16; ++i) { const int kk = (i & 3) + 8 * (i >> 2) + 4 * h; if (kk < r) S[0][i] = -1e30f; if (kk > r) S[4][i] = -1e30f; }
    float mx = -1e30f;
#pragma unroll
    for (int kt = 0; kt < 5; ++kt) { if (kt >= kt_lo) {
#pragma unroll
        for (int i = 0; i < 16; ++i) mx = fmaxf(mx, S[kt][i]); } }
    mx = fmaxf(mx, __shfl_xor(mx, 32));
    float l = 0.f;
#pragma unroll
    for (int kt = 0; kt < 5; ++kt) { if (kt >= kt_lo) {
#pragma unroll
        for (int i = 0; i < 16; ++i) { const float p = __builtin_amdgcn_exp2f(S[kt][i] - mx); S[kt][i] = p; l += p; } } }
    l += __shfl_xor(l, 32);
    f32x16 o[4];
#pragma unroll
    for (int dt = 0; dt < 4; ++dt)
#pragma unroll
        for (int i = 0; i < 16; ++i) o[dt][i] = 0.f;
#pragma unroll
    for (int kt = 0; kt < 5; ++kt) {
        if (kt >= kt_lo) {
#pragma unroll
            for (int s2 = 0; s2 < 2; ++s2) {
                const bf16x8 pf = pack8(S[kt][8 * s2], S[kt][8 * s2 + 1], S[kt][8 * s2 + 2], S[kt][8 * s2 + 3], S[kt][8 * s2 + 4], S[kt][8 * s2 + 5], S[kt][8 * s2 + 6], S[kt][8 * s2 + 7]);
                const LAS unsigned char* vp = F.lds + ATT_VS + r * ATT_VSTR + (32 * (sb + kt) + 16 * s2 + 4 * h) * 2;
#pragma unroll
                for (int dt = 0; dt < 4; ++dt) { const u32x2 lo = *(const LAS u32x2*)(vp + dt * 32 * ATT_VSTR), hi = *(const LAS u32x2*)(vp + dt * 32 * ATT_VSTR + 16);
                    u32x4 vv; vv.x = lo.x; vv.y = lo.y; vv.z = hi.x; vv.w = hi.y;
                    o[dt] = MFMA32(__builtin_bit_cast(bf16x8, vv), pf, o[dt]); }
            }
        }
    }
    const float inv = __builtin_amdgcn_rcpf(l), lse = (mx + __log2f(l)) * 0.6931471805599453f;
    bf16_t* og = (bf16_t*)(A.ws + WS_OG);
    float* lsep = (float*)(A.ws + WS_LSE);
    if (!LAST) {
        const int gs = g ? 1 : 0;
        bf16_t* dst = og + ((size_t)gs * MP + qrow) * 1024 + slot * 128 + 4 * h;
#pragma unroll
        for (int dt = 0; dt < 4; ++dt)
#pragma unroll
            for (int i4 = 0; i4 < 4; ++i4) { u32x2 w; w.x = pkc(o[dt][4 * i4] * inv, o[dt][4 * i4 + 1] * inv); w.y = pkc(o[dt][4 * i4 + 2] * inv, o[dt][4 * i4 + 3] * inv);
                *(u32x2*)(dst + 32 * dt + 8 * i4) = w; }
        if (h == 0) lsep[((size_t)gs * MP + qrow) * 8 + slot] = lse;
    } else {
        const float l0 = lsep[((size_t)0 * MP + qrow) * 8 + slot], l1 = lsep[((size_t)1 * MP + qrow) * 8 + slot];
        const float ml = fmaxf(fmaxf(l0, l1), lse); const float w0 = __expf(l0 - ml), w1 = __expf(l1 - ml), w2 = __expf(lse - ml); const float wi = __builtin_amdgcn_rcpf(w0 + w1 + w2);
        const float c0 = w0 * wi, c1 = w1 * wi, c2 = w2 * wi * inv;
        const bf16_t* s0 = og + ((size_t)0 * MP + qrow) * 1024 + slot * 128 + 4 * h; const bf16_t* s1 = og + ((size_t)1 * MP + qrow) * 1024 + slot * 128 + 4 * h;
        bf16_t* dst = (bf16_t*)(A.ws + WS_ON) + qrow * 1024 + slot * 128 + 4 * h;
#pragma unroll
        for (int dt = 0; dt < 4; ++dt)
#pragma unroll
            for (int i4 = 0; i4 < 4; ++i4) { const u32x2 a = *(const u32x2*)(s0 + 32 * dt + 8 * i4), bb = *(const u32x2*)(s1 + 32 * dt + 8 * i4);
                u32x2 w; w.x = pkc(c0 * bflo(a.x) + c1 * bflo(bb.x) + c2 * o[dt][4 * i4], c0 * bfhi(a.x) + c1 * bfhi(bb.x) + c2 * o[dt][4 * i4 + 1]);
                w.y = pkc(c0 * bflo(a.y) + c1 * bflo(bb.y) + c2 * o[dt][4 * i4 + 2], c0 * bfhi(a.y) + c1 * bfhi(bb.y) + c2 * o[dt][4 * i4 + 3]);
                *(u32x2*)(dst + 32 * dt + 8 * i4) = w; }
    }
    LDS_BARRIER();
}

__device__ __forceinline__ void vt_build(const Args& A, Frame& F) {
    const int tid = F.tid;
    const float* kv = (const float*)(A.ws + WS_KVRAW);
    bf16_t* vt = (bf16_t*)(A.ws + WS_VT);
    LAS unsigned char* L = F.lds;
    for (int item = blockIdx.x; item < 256; item += gridDim.x) {
        const int bk = item >> 3, P0 = (item & 7) * 256, b = bk >> 2, kvh = bk & 3;
#pragma unroll 4
        for (int i = 0; i < 16; ++i) { const int e = tid + 512 * i, row = e >> 5, c4 = e & 31;
            const f32x4 v = *(const f32x4*)(kv + ((size_t)(b * SEQ + P0 + row)) * 1024 + 512 + kvh * 128 + 4 * c4);
            u32x2 w; w.x = pkc(v[0], v[1]); w.y = pkc(v[2], v[3]); *(LAS u32x2*)(L + row * 272 + c4 * 8) = w; }
        LDS_BARRIER();
#pragma unroll 2
        for (int i = 0; i < 8; ++i) { const int e = tid + 512 * i, d = e & 127;
            { const int ch = e >> 7;
              unsigned short x[8];
#pragma unroll
              for (int jj = 0; jj < 8; ++jj) x[jj] = *(const LAS unsigned short*)(L + (8 * ch + jj) * 272 + d * 2);
              u32x4 w; w.x = x[0] | ((unsigned)x[1] << 16); w.y = x[2] | ((unsigned)x[3] << 16); w.z = x[4] | ((unsigned)x[5] << 16); w.w = x[6] | ((unsigned)x[7] << 16);
              *(u32x4*)(vt + ((size_t)(bk * 128 + d)) * 2048 + P0 + 8 * ch) = w; }
            { const int c = (e >> 7) & 3, uc = e >> 9;
              unsigned short x[8];
#pragma unroll
              for (int jj = 0; jj < 8; ++jj) x[jj] = *(const LAS unsigned short*)(L + (4 * (8 * uc + jj) + c) * 272 + d * 2);
              u32x4 w; w.x = x[0] | ((unsigned)x[1] << 16); w.y = x[2] | ((unsigned)x[3] << 16); w.z = x[4] | ((unsigned)x[5] << 16); w.w = x[6] | ((unsigned)x[7] << 16);
              *(u32x4*)(vt + (size_t)MP * 512 + ((size_t)((bk * 4 + c) * 128 + d)) * 512 + (P0 >> 2) + 8 * uc) = w; }
            { const int c = (e >> 7) & 15, uc = e >> 11;
              unsigned short x[8];
#pragma unroll
              for (int jj = 0; jj < 8; ++jj) x[jj] = *(const LAS unsigned short*)(L + (16 * (8 * uc + jj) + c) * 272 + d * 2);
              u32x4 w; w.x = x[0] | ((unsigned)x[1] << 16); w.y = x[2] | ((unsigned)x[3] << 16); w.z = x[4] | ((unsigned)x[5] << 16); w.w = x[6] | ((unsigned)x[7] << 16);
              *(u32x4*)(vt + (size_t)2 * MP * 512 + ((size_t)((bk * 16 + c) * 128 + d)) * 128 + (P0 >> 4) + 8 * uc) = w; }
        }
        LDS_BARRIER();
    }
}
constexpr int G1_TOT = 4096, G1_QI = 8192, G1_KI = 25600, G1_VT = 43008;
constexpr int G2_QI = 0, G2_KET = 17408, G2_VT = 35840, G2_DEC = 72704, G2_SS = 73216, G2_ATT = 75264, G2_ONM = 84480;
__device__ __forceinline__ unsigned short f2bf_u(float x) { return (unsigned short)(pkc(x, 0.f) & 0xffffu); }

__device__ __forceinline__ void gla_g1_item(const Args& A, Frame& F, int l, int item) {
    const int tid = F.tid, lane = F.lane, wv = F.wave, r = lane & 31, hh = lane >> 5;
    const int b = item >> 5, n = item & 31, row0 = b * SEQ + 64 * n;
    LAS unsigned char* L = F.lds; LAS float* GL = (LAS float*)L; LAS float* TOT = (LAS float*)(L + G1_TOT);
    const bf16_t* proj = (const bf16_t*)(A.ws + WS_PROJ); const float* glr = (const float*)(A.ws + WS_GLR);
    bf16_t* qig = (bf16_t*)(A.ws + WS_QIG); bf16_t* ketg = (bf16_t*)(A.ws + WS_KETG); bf16_t* vtg = (bf16_t*)(A.ws + WS_VTG); float* decg = (float*)(A.ws + WS_DECG);
    bf16_t* on = (bf16_t*)(A.ws + WS_ON);
    for (int e = tid; e < 1024; e += 512) GL[e] = glr[(size_t)row0 * 16 + e];
    LDS_BARRIER();
    const int dk = tid & 127, tq = tid >> 7;
    for (int head = 0; head < 4; ++head) {
        const size_t idx = (size_t)item * 4 + head;
        float cl[16]; unsigned short qraw[16], kraw[16];
        {
            float w[16];
#pragma unroll
            for (int j = 0; j < 16; ++j) w[j] = A.in[9][(size_t)l * 16 * 512 + j * 512 + head * 128 + dk];
            const float bias = A.in[10][l * 512 + head * 128 + dk];
#pragma unroll
            for (int i = 0; i < 16; ++i) { const size_t row = (size_t)(row0 + 16 * tq + i); qraw[i] = proj[row * NPROJ + head * 128 + dk]; kraw[i] = proj[row * NPROJ + 512 + head * 128 + dk]; }
            float run = 0.f;
#pragma unroll
            for (int i = 0; i < 16; ++i) { const LAS float* gp = GL + (16 * tq + i) * 16; float z = bias;
#pragma unroll
                for (int q4 = 0; q4 < 4; ++q4) { const f32x4 gv = *(const LAS f32x4*)(gp + 4 * q4); z += (gv[0] * w[4 * q4] + gv[1] * w[4 * q4 + 1]) + (gv[2] * w[4 * q4 + 2] + gv[3] * w[4 * q4 + 3]); }
                const float ls = fminf(z, 0.f) - __logf(1.0f + __expf(-fabsf(z)));
                run += ls * (1.0f / 16.0f); cl[i] = run; }
            TOT[tq * 128 + dk] = run;
        }
#pragma unroll
        for (int i = 0; i < 4; ++i) { const int e = tid + 512 * i, t = e & 63, pc = e >> 6;
            const u32x4 v = *(const u32x4*)(proj + (size_t)(row0 + t) * NPROJ + 1024 + head * 256 + 8 * pc);
            LAS unsigned char* dst = L + G1_VT + (8 * pc) * 144 + 2 * t;
            *(LAS unsigned short*)(dst + 0 * 144) = (unsigned short)(v.x & 0xffffu); *(LAS unsigned short*)(dst + 1 * 144) = (unsigned short)(v.x >> 16);
            *(LAS unsigned short*)(dst + 2 * 144) = (unsigned short)(v.y & 0xffffu); *(LAS unsigned short*)(dst + 3 * 144) = (unsigned short)(v.y >> 16);
            *(LAS unsigned short*)(dst + 4 * 144) = (unsigned short)(v.z & 0xffffu); *(LAS unsigned short*)(dst + 5 * 144) = (unsigned short)(v.z >> 16);
            *(LAS unsigned short*)(dst + 6 * 144) = (unsigned short)(v.w & 0xffffu); *(LAS unsigned short*)(dst + 7 * 144) = (unsigned short)(v.w >> 16); }
        LDS_BARRIER();
        {
            float off = 0.f, last = 0.f;
#pragma unroll
            for (int q = 0; q < 4; ++q) { const float tv = TOT[q * 128 + dk]; last += tv; off += (q < tq) ? tv : 0.f; }
            unsigned short ke[16];
#pragma unroll
            for (int i = 0; i < 16; ++i) { const float cum = off + cl[i]; const int t = 16 * tq + i;
                const float q = bf2f(qraw[i]), k = bf2f(kraw[i]);
                const unsigned short qi = f2bf_u(q * __expf(cum)), ki = f2bf_u(k * __expf(-cum)); ke[i] = f2bf_u(k * __expf(last - cum));
                *(LAS unsigned short*)(L + G1_QI + t * 272 + 2 * dk) = qi; *(LAS unsigned short*)(L + G1_KI + t * 272 + 2 * dk) = ki;
                qig[(idx * 64 + t) * 128 + dk] = qi; }
            u32x4 k0, k1; k0.x = ke[0] | ((unsigned)ke[1] << 16); k0.y = ke[2] | ((unsigned)ke[3] << 16); k0.z = ke[4] | ((unsigned)ke[5] << 16); k0.w = ke[6] | ((unsigned)ke[7] << 16);
            k1.x = ke[8] | ((unsigned)ke[9] << 16); k1.y = ke[10] | ((unsigned)ke[11] << 16); k1.z = ke[12] | ((unsigned)ke[13] << 16); k1.w = ke[14] | ((unsigned)ke[15] << 16);
            bf16_t* kd = ketg + (idx * 128 + dk) * 64 + 16 * tq; *(u32x4*)kd = k0; *(u32x4*)(kd + 8) = k1;
            if (tq == 0) decg[idx * 128 + dk] = __expf(last);
        }
        LDS_BARRIER();
#pragma unroll
        for (int i = 0; i < 4; ++i) { const int e = tid + 512 * i, t = e >> 5, pc = e & 31;
            bf16_t* rp = (bf16_t*)proj + (size_t)(row0 + t) * NPROJ + 2048 + head * 256 + 8 * pc; const u32x4 rw = *(const u32x4*)rp;
            const float* gp = A.in[11] + l * 256 + 8 * pc; const f32x4 g0 = *(const f32x4*)gp, g1 = *(const f32x4*)(gp + 4);
            const float r0 = bflo(rw.x), r1 = bfhi(rw.x), r2 = bflo(rw.y), r3 = bfhi(rw.y), r4 = bflo(rw.z), r5 = bfhi(rw.z), r6 = bflo(rw.w), r7 = bfhi(rw.w);
            u32x4 o; o.x = pkc(r0 * pg8::fast_sigmoid(r0) * g0[0], r1 * pg8::fast_sigmoid(r1) * g0[1]); o.y = pkc(r2 * pg8::fast_sigmoid(r2) * g0[2], r3 * pg8::fast_sigmoid(r3) * g0[3]);
            o.z = pkc(r4 * pg8::fast_sigmoid(r4) * g1[0], r5 * pg8::fast_sigmoid(r5) * g1[1]); o.w = pkc(r6 * pg8::fast_sigmoid(r6) * g1[2], r7 * pg8::fast_sigmoid(r7) * g1[3]);
            *(u32x4*)rp = o; }
#pragma unroll
        for (int i = 0; i < 4; ++i) { const int e = tid + 512 * i, dv = e >> 3, pc = e & 7; *(u32x4*)(vtg + (idx * 256 + dv) * 64 + 8 * pc) = *(const LAS u32x4*)(L + G1_VT + dv * 144 + pc * 16); }
        if (wv < 3) {
            const int ta = wv == 2 ? 1 : 0, tb = wv == 0 ? 0 : 1;
            f32x16 at;
#pragma unroll
            for (int i = 0; i < 16; ++i) at[i] = 0.f;
#pragma unroll
            for (int s = 0; s < 8; ++s) {
                const bf16x8 kf = *(const LAS bf16x8*)(L + G1_KI + (32 * ta + r) * 272 + 32 * s + 16 * hh);
                const bf16x8 qf = *(const LAS bf16x8*)(L + G1_QI + (32 * tb + r) * 272 + 32 * s + 16 * hh);
                at = MFMA32(kf, qf, at); }
            if (ta == tb) {
#pragma unroll
                for (int i = 0; i < 16; ++i) { const int sl = (i & 3) + 8 * (i >> 2) + 4 * hh; if (sl > r) at[i] = 0.f; } }
            bf16_t* ad = (bf16_t*)(A.ws + WS_ATTG) + (idx * 64 + 32 * tb + r) * 64 + 32 * ta + 4 * hh;
#pragma unroll
            for (int i4 = 0; i4 < 4; ++i4) { u32x2 w; w.x = pkc(at[4 * i4], at[4 * i4 + 1]); w.y = pkc(at[4 * i4 + 2], at[4 * i4 + 3]); *(u32x2*)(ad + 8 * i4) = w; }
        }
        LDS_BARRIER();
    }
}

__device__ __forceinline__ void gla_g2_seq(const Args& A, Frame& F, int l, int bh) {
    const int tid = F.tid, lane = F.lane, wv = F.wave, r = lane & 31, hh = lane >> 5;
    const int b = bh >> 2, head = bh & 3;
    LAS unsigned char* L = F.lds;
    const bf16_t* proj = (const bf16_t*)(A.ws + WS_PROJ);
    const bf16_t* qig = (const bf16_t*)(A.ws + WS_QIG); const bf16_t* ketg = (const bf16_t*)(A.ws + WS_KETG); const bf16_t* vtg = (const bf16_t*)(A.ws + WS_VTG); const float* decg = (const float*)(A.ws + WS_DECG);
    bf16_t* on = (bf16_t*)(A.ws + WS_ON); const bf16_t* attg = (const bf16_t*)(A.ws + WS_ATTG);
    f32x16 S[4];
#pragma unroll
    for (int kt = 0; kt < 4; ++kt)
#pragma unroll
        for (int i = 0; i < 16; ++i) S[kt][i] = 0.f;
    u32x4 pq[2], pk[2], pv[4], pa; f32x4 pd = (f32x4){0.f, 0.f, 0.f, 0.f};
#define G2_LOAD(nn) do { const size_t idx_ = ((size_t)(b * 32 + (nn)) * 4 + head); \
        pq[0] = *(const u32x4*)(qig + idx_ * 8192 + (size_t)tid * 8); pq[1] = *(const u32x4*)(qig + idx_ * 8192 + (size_t)(tid + 512) * 8); \
        pk[0] = *(const u32x4*)(ketg + idx_ * 8192 + (size_t)tid * 8); pk[1] = *(const u32x4*)(ketg + idx_ * 8192 + (size_t)(tid + 512) * 8); \
        _Pragma("unroll") for (int i_ = 0; i_ < 4; ++i_) pv[i_] = *(const u32x4*)(vtg + idx_ * 16384 + (size_t)(tid + 512 * i_) * 8); \
        pa = *(const u32x4*)(attg + idx_ * 4096 + (size_t)tid * 8); \
        if (tid < 32) pd = *(const f32x4*)(decg + idx_ * 128 + tid * 4); } while (0)
#define G2_STORE() do { \
        _Pragma("unroll") for (int i_ = 0; i_ < 2; ++i_) { const int e_ = tid + 512 * i_; *(LAS u32x4*)(L + G2_QI + (e_ >> 4) * 272 + (e_ & 15) * 16) = pq[i_]; *(LAS u32x4*)(L + G2_KET + (e_ >> 3) * 144 + (e_ & 7) * 16) = pk[i_]; } \
        _Pragma("unroll") for (int i_ = 0; i_ < 4; ++i_) { const int e_ = tid + 512 * i_; *(LAS u32x4*)(L + G2_VT + (e_ >> 3) * 144 + (e_ & 7) * 16) = pv[i_]; } \
        *(LAS u32x4*)(L + G2_ATT + (tid >> 3) * 144 + (tid & 7) * 16) = pa; \
        if (tid < 32) *(LAS f32x4*)(L + G2_DEC + tid * 16) = pd; } while (0)
    G2_LOAD(0); G2_STORE(); LDS_BARRIER();
    for (int n = 0; n < 32; ++n) {
        asm volatile("; G2_STEP_BEGIN");
        if (n + 1 < 32) G2_LOAD(n + 1);
        const size_t rowa = (size_t)(b * SEQ + 64 * n + r), rowb = rowa + 32;
        u32x2 rr[2][4];
#pragma unroll
        for (int i4 = 0; i4 < 4; ++i4) { rr[0][i4] = *(const u32x2*)(proj + rowa * NPROJ + 2048 + head * 256 + 32 * wv + 8 * i4 + 4 * hh); rr[1][i4] = *(const u32x2*)(proj + rowb * NPROJ + 2048 + head * 256 + 32 * wv + 8 * i4 + 4 * hh); }
        __builtin_amdgcn_sched_barrier(0);
        f32x16 z0, z1;
#pragma unroll
        for (int i = 0; i < 16; ++i) { z0[i] = 0.f; z1[i] = 0.f; }
        bf16x8 vfr[4];
#pragma unroll
        for (int s = 0; s < 4; ++s) vfr[s] = *(const LAS bf16x8*)(L + G2_VT + (32 * wv + r) * 144 + (16 * s + 8 * hh) * 2);
#pragma unroll
        for (int s = 0; s < 4; ++s) {
            if (s < 2) { const bf16x8 af = *(const LAS bf16x8*)(L + G2_ATT + r * 144 + (16 * s + 8 * hh) * 2); z0 = MFMA32(vfr[s], af, z0); }
            const bf16x8 bfg = *(const LAS bf16x8*)(L + G2_ATT + (32 + r) * 144 + (16 * s + 8 * hh) * 2); z1 = MFMA32(vfr[s], bfg, z1); }
#pragma unroll
        for (int kt = 0; kt < 4; ++kt)
#pragma unroll
            for (int s = 0; s < 2; ++s) {
                const bf16x8 af = pack8(S[kt][8 * s], S[kt][8 * s + 1], S[kt][8 * s + 2], S[kt][8 * s + 3], S[kt][8 * s + 4], S[kt][8 * s + 5], S[kt][8 * s + 6], S[kt][8 * s + 7]);
                const LAS unsigned char* qp = L + G2_QI + r * 272 + (32 * kt + 16 * s + 4 * hh) * 2;
                { const u32x2 lo = *(const LAS u32x2*)(qp), hi = *(const LAS u32x2*)(qp + 16); u32x4 vv; vv.x = lo.x; vv.y = lo.y; vv.z = hi.x; vv.w = hi.y; z0 = MFMA32(af, __builtin_bit_cast(bf16x8, vv), z0); }
                { const u32x2 lo = *(const LAS u32x2*)(qp + 32 * 272), hi = *(const LAS u32x2*)(qp + 32 * 272 + 16); u32x4 vv; vv.x = lo.x; vv.y = lo.y; vv.z = hi.x; vv.w = hi.y; z1 = MFMA32(af, __builtin_bit_cast(bf16x8, vv), z1); }
            }
        asm volatile("" ::: "memory");
        bf16x8 vfu[4];
#pragma unroll
        for (int s = 0; s < 4; ++s) vfu[s] = *(const LAS bf16x8*)(L + G2_VT + (32 * wv + r) * 144 + (16 * s + 8 * hh) * 2);
#pragma unroll
        for (int kt = 0; kt < 4; ++kt) {
#pragma unroll
            for (int i4 = 0; i4 < 4; ++i4) { const f32x4 d4 = *(const LAS f32x4*)(L + G2_DEC + (32 * kt + 8 * i4 + 4 * hh) * 4);
                S[kt][4 * i4] *= d4[0]; S[kt][4 * i4 + 1] *= d4[1]; S[kt][4 * i4 + 2] *= d4[2]; S[kt][4 * i4 + 3] *= d4[3]; }
#pragma unroll
            for (int s = 0; s < 4; ++s) { const bf16x8 kf = *(const LAS bf16x8*)(L + G2_KET + (32 * kt + r) * 144 + (16 * s + 8 * hh) * 2); S[kt] = MFMA32(kf, vfu[s], S[kt]); }
        }
        float oa[16], ob[16]; float ssa = 0.f, ssb = 0.f;
#pragma unroll
        for (int i4 = 0; i4 < 4; ++i4) {
            oa[4 * i4] = z0[4 * i4]; oa[4 * i4 + 1] = z0[4 * i4 + 1]; oa[4 * i4 + 2] = z0[4 * i4 + 2]; oa[4 * i4 + 3] = z0[4 * i4 + 3];
            ob[4 * i4] = z1[4 * i4]; ob[4 * i4 + 1] = z1[4 * i4 + 1]; ob[4 * i4 + 2] = z1[4 * i4 + 2]; ob[4 * i4 + 3] = z1[4 * i4 + 3]; }
#pragma unroll
        for (int i = 0; i < 16; ++i) { ssa += oa[i] * oa[i]; ssb += ob[i] * ob[i]; }
        ssa += __shfl_xor(ssa, 32); ssb += __shfl_xor(ssb, 32);
        if (hh == 0) { *(LAS float*)(L + G2_SS + (wv * 64 + r) * 4) = ssa; *(LAS float*)(L + G2_SS + (wv * 64 + 32 + r) * 4) = ssb; }
        LDS_BARRIER();
        float ta = 0.f, tb = 0.f;
#pragma unroll
        for (int w = 0; w < 8; ++w) { ta += *(const LAS float*)(L + G2_SS + (w * 64 + r) * 4); tb += *(const LAS float*)(L + G2_SS + (w * 64 + 32 + r) * 4); }
        const float rsa = __builtin_amdgcn_rsqf(ta * (1.0f / 256.0f) + EPS), rsb = __builtin_amdgcn_rsqf(tb * (1.0f / 256.0f) + EPS);
#pragma unroll
        for (int i4 = 0; i4 < 4; ++i4) {
            u32x2 w; w.x = pkc(oa[4 * i4] * rsa * bflo(rr[0][i4].x), oa[4 * i4 + 1] * rsa * bfhi(rr[0][i4].x)); w.y = pkc(oa[4 * i4 + 2] * rsa * bflo(rr[0][i4].y), oa[4 * i4 + 3] * rsa * bfhi(rr[0][i4].y));
            *(u32x2*)(on + rowa * D + head * 256 + 32 * wv + 8 * i4 + 4 * hh) = w;
            u32x2 w2; w2.x = pkc(ob[4 * i4] * rsb * bflo(rr[1][i4].x), ob[4 * i4 + 1] * rsb * bfhi(rr[1][i4].x)); w2.y = pkc(ob[4 * i4 + 2] * rsb * bflo(rr[1][i4].y), ob[4 * i4 + 3] * rsb * bfhi(rr[1][i4].y));
            *(u32x2*)(on + rowb * D + head * 256 + 32 * wv + 8 * i4 + 4 * hh) = w2; }
        if (n + 1 < 32) G2_STORE();
        asm volatile("; G2_STEP_END");
        LDS_BARRIER();
    }
#undef G2_LOAD
#undef G2_STORE
    float* so = A.out + OUT_GSP + (((size_t)l * NBP + b) * 4 + head) * 128 * 256 + 32 * wv + r;
#pragma unroll
    for (int kt = 0; kt < 4; ++kt)
#pragma unroll
        for (int i = 0; i < 16; ++i) so[(size_t)(32 * kt + (i & 3) + 8 * (i >> 2) + 4 * hh) * 256] = S[kt][i];
}
constexpr int SA_QS = 0, SA_SC = 12672, SA_OG = 25344, SA_LSE = 49920, SA_STR = 132;
__device__ __forceinline__ int sa_slot(int idx) { return idx >= PAST ? 896 + (idx - PAST) : (idx >= 1536 ? idx - 1536 : 512 + ((idx >> 4) << 2) + (idx & 15)); }
__device__ __forceinline__ void satt_item(const Args& A, Frame& F, int j, int item) {
    const int tid = F.tid, lane = F.lane, wv = F.wave;
    const int b = item >> 2, kvh = item & 3;
    LAS float* qs = (LAS float*)(F.lds + SA_QS); LAS float* sc = (LAS float*)(F.lds + SA_SC); LAS float* og = (LAS float*)(F.lds + SA_OG); LAS float* lsel = (LAS float*)(F.lds + SA_LSE);
    const bf16_t* proj = (const bf16_t*)(A.ws + WS_PROJ);
    const bf16_t* ckp = (const bf16_t*)(A.ws + WS_CK) + (size_t)item * 900 * 128; const bf16_t* cvp = (const bf16_t*)(A.ws + WS_CV) + (size_t)item * 900 * 128;
    const float* qn = A.in[18] + j * 128;
#pragma unroll
    for (int k3 = 0; k3 < 3; ++k3) {
        const int qi = 3 * wv + k3, g = qi >> 3, t = (qi >> 1) & 3, hq = qi & 1; const int row = MP + TS * b + t; const int pos = PAST + t;
        const unsigned qw = *(const unsigned*)(proj + (size_t)row * NPROJ + g * 1024 + (kvh * 2 + hq) * 128 + 2 * lane);
        float q0 = bflo(qw), q1 = bfhi(qw);
        const float rs = __builtin_amdgcn_rsqf(wave_sum(q0 * q0 + q1 * q1) * (1.0f / 128.0f) + EPS);
        q0 *= rs * qn[2 * lane]; q1 *= rs * qn[2 * lane + 1];
        { const float o0 = __shfl_xor(q0, 8), o1 = __shfl_xor(q1, 8);
          if (lane < 16) { const int i0 = (2 * lane) & 15; const f32x4 cs = *(const f32x4*)((const float*)(A.ws + WS_ROPE) + ((size_t)pos * 16 + i0) * 2);
              if (lane < 8) { q0 = q0 * cs[0] - o0 * cs[1]; q1 = q1 * cs[2] - o1 * cs[3]; } else { q0 = q0 * cs[0] + o0 * cs[1]; q1 = q1 * cs[2] + o1 * cs[3]; } } }
        qs[qi * SA_STR + 2 * lane] = q0 * 0.08838834764831845f; qs[qi * SA_STR + 2 * lane + 1] = q1 * 0.08838834764831845f;
    }
    LDS_BARRIER();
    {
        const int r = lane & 31, h = lane >> 5;
        bf16x8 qf[8];
#pragma unroll
        for (int s2 = 0; s2 < 8; ++s2) { f32x4 a = (f32x4){0.f, 0.f, 0.f, 0.f}, c = a;
            if (r < 24) { a = *(const LAS f32x4*)(qs + r * SA_STR + 16 * s2 + 8 * h); c = *(const LAS f32x4*)(qs + r * SA_STR + 16 * s2 + 8 * h + 4); }
            qf[s2] = pack8(a[0], a[1], a[2], a[3], c[0], c[1], c[2], c[3]); }
#pragma unroll 2
        for (int k = 0; k < 8; ++k) { const int tt = wv + 8 * k;
            if (tt < 60) { const int L = tt / 5, p = tt - 5 * L, g = L >> 2, t = L & 3;
                int i = 32 * p + r; i = i > 128 ? 128 : i; const int idx = PAST + t - (i << (2 * g));
                const bf16_t* kr = ckp + (size_t)sa_slot(idx) * 128 + 8 * h;
                bf16x8 kf[8];
#pragma unroll
                for (int s2 = 0; s2 < 8; ++s2) kf[s2] = *(const bf16x8*)(kr + 16 * s2);
                f32x16 acc;
#pragma unroll
                for (int i2 = 0; i2 < 16; ++i2) acc[i2] = 0.f;
#pragma unroll
                for (int s2 = 0; s2 < 8; ++s2) acc = MFMA32(kf[s2], qf[s2], acc);
                if ((r >> 1) == L) { LAS float* dst = sc + r * SA_STR + 32 * p + 4 * h;
#pragma unroll
                    for (int i4 = 0; i4 < 4; ++i4) { if (32 * p + 8 * i4 + 4 * h + 3 <= 131) *(LAS f32x4*)(dst + 8 * i4) = (f32x4){acc[4 * i4], acc[4 * i4 + 1], acc[4 * i4 + 2], acc[4 * i4 + 3]}; } }
            }
        }
    }
    LDS_BARRIER();
#pragma unroll
    for (int k3 = 0; k3 < 3; ++k3) {
        const int qi = 3 * wv + k3; LAS float* row = sc + qi * SA_STR;
        const float a0 = row[lane], a1 = row[lane + 64], a2 = lane == 0 ? row[128] : -1e30f;
        const float mx = wave_max(fmaxf(fmaxf(a0, a1), a2));
        const float p0 = __expf(a0 - mx), p1 = __expf(a1 - mx), p2 = lane == 0 ? __expf(a2 - mx) : 0.f;
        const float sum = wave_sum(p0 + p1 + p2); const float inv = __builtin_amdgcn_rcpf(sum);
        row[lane] = p0 * inv; row[lane + 64] = p1 * inv; if (lane == 0) { row[128] = p2 * inv; lsel[qi] = mx + __logf(sum); }
    }
    LDS_BARRIER();
    if (tid < 384) {
        const int gt = tid >> 5, part = (tid >> 4) & 1, dl = tid & 15, g = gt >> 2, t = gt & 3;
        const LAS float* pa = sc + (gt * 2) * SA_STR; const LAS float* pb = pa + SA_STR;
        float acc0[8], acc1[8];
#pragma unroll
        for (int q = 0; q < 8; ++q) { acc0[q] = 0.f; acc1[q] = 0.f; }
        const int i0 = part ? 65 : 0, i1 = part ? 129 : 65;
#pragma unroll 13
        for (int i = i0; i < i1; ++i) { const int idx = PAST + t - (i << (2 * g));
            const u32x4 vw = *(const u32x4*)(cvp + (size_t)sa_slot(idx) * 128 + 8 * dl); const float p0 = pa[i], p1 = pb[i];
            const float v0 = bflo(vw.x), v1 = bfhi(vw.x), v2 = bflo(vw.y), v3 = bfhi(vw.y), v4 = bflo(vw.z), v5 = bfhi(vw.z), v6 = bflo(vw.w), v7 = bfhi(vw.w);
            acc0[0] += p0 * v0; acc0[1] += p0 * v1; acc0[2] += p0 * v2; acc0[3] += p0 * v3; acc0[4] += p0 * v4; acc0[5] += p0 * v5; acc0[6] += p0 * v6; acc0[7] += p0 * v7;
            acc1[0] += p1 * v0; acc1[1] += p1 * v1; acc1[2] += p1 * v2; acc1[3] += p1 * v3; acc1[4] += p1 * v4; acc1[5] += p1 * v5; acc1[6] += p1 * v6; acc1[7] += p1 * v7; }
        LAS float* o0 = og + (part * 24 + gt * 2) * 128 + 8 * dl; LAS float* o1 = o0 + 128;
        *(LAS f32x4*)o0 = (f32x4){acc0[0], acc0[1], acc0[2], acc0[3]}; *(LAS f32x4*)(o0 + 4) = (f32x4){acc0[4], acc0[5], acc0[6], acc0[7]};
        *(LAS f32x4*)o1 = (f32x4){acc1[0], acc1[1], acc1[2], acc1[3]}; *(LAS f32x4*)(o1 + 4) = (f32x4){acc1[4], acc1[5], acc1[6], acc1[7]};
    }
    LDS_BARRIER();
    {
        const int t = wv >> 1, hq = wv & 1;
        const float l0 = lsel[(0 * 4 + t) * 2 + hq], l1 = lsel[(1 * 4 + t) * 2 + hq], l2 = lsel[(2 * 4 + t) * 2 + hq];
        const float ml = fmaxf(fmaxf(l0, l1), l2); const float w0 = __expf(l0 - ml), w1 = __expf(l1 - ml), w2 = __expf(l2 - ml); const float wi = __builtin_amdgcn_rcpf(w0 + w1 + w2);
        const LAS float* o0 = og + ((0 * 4 + t) * 2 + hq) * 128 + 2 * lane; const LAS float* o1 = og + ((1 * 4 + t) * 2 + hq) * 128 + 2 * lane; const LAS float* o2 = og + ((2 * 4 + t) * 2 + hq) * 128 + 2 * lane;
        const float r0 = (w0 * (o0[0] + o0[24 * 128]) + w1 * (o1[0] + o1[24 * 128]) + w2 * (o2[0] + o2[24 * 128])) * wi, r1 = (w0 * (o0[1] + o0[24 * 128 + 1]) + w1 * (o1[1] + o1[24 * 128 + 1]) + w2 * (o2[1] + o2[24 * 128 + 1])) * wi;
        *(unsigned*)((bf16_t*)(A.ws + WS_ON) + (size_t)(MP + TS * b + t) * D + (kvh * 2 + hq) * 128 + 2 * lane) = pkc(r0, r1);
    }
    LDS_BARRIER();
}
typedef float sf32x4 __attribute__((ext_vector_type(4)));
struct SPre { float s; u32x2 x, p; };
struct SEpiScale {
    static constexpr bool SWIGLU = false;
    bf16_t* O; int ldc; const float* ssq; int col_f32; float* Fp; int ldf;
    __device__ __forceinline__ SPre prefetch(int row, int tn, int cg) const { SPre q; q.s = ssq ? pg8::rstd_of(ssq, row - MP) : 1.0f; q.x = (u32x2){0u, 0u}; q.p = q.x; return q; }
    __device__ __forceinline__ void apply(int row, int tn, int cg, sf32x4 v, const SPre& q) const {
        const int col = 32 * tn + 4 * cg; v = v * q.s;
        if (col >= col_f32) *(sf32x4*)(Fp + (size_t)row * ldf + (col - col_f32)) = v;
        else { u32x2 w; w.x = pkc(v[0], v[1]); w.y = pkc(v[2], v[3]); *(u32x2*)(O + (size_t)row * ldc + col) = w; }
    }
};
struct SEpiSwiglu {
    static constexpr bool SWIGLU = true;
    bf16_t* H; const float* ssq;
    __device__ __forceinline__ SPre prefetch(int row, int tn, int cg) const { SPre q; q.s = pg8::rstd_of(ssq, row - MP); q.x = (u32x2){0u, 0u}; q.p = q.x; return q; }
    __device__ __forceinline__ void apply(int row, int tn, int cg, sf32x4 v, const SPre& q) const {
        v = v * q.s;
        sf32x4 pv; pv[0] = __shfl_xor(v[0], 4); pv[1] = __shfl_xor(v[1], 4); pv[2] = __shfl_xor(v[2], 4); pv[3] = __shfl_xor(v[3], 4);
        if (cg < 4) { u32x2 w; w.x = pkc(v[0] * pg8::fast_sigmoid(v[0]) * pv[0], v[1] * pg8::fast_sigmoid(v[1]) * pv[1]); w.y = pkc(v[2] * pg8::fast_sigmoid(v[2]) * pv[2], v[3] * pg8::fast_sigmoid(v[3]) * pv[3]);
            *(u32x2*)(H + (size_t)row * FF + 16 * tn + 4 * cg) = w; }
    }
};
template <int MODE> struct SEpiRes {
    static constexpr bool SWIGLU = false;
    const bf16_t* Xin; bf16_t* XBo; float* ssq_out; const float* ssq_in; const bf16_t* PP; float* Yf;
    __device__ __forceinline__ SPre prefetch(int row, int tn, int cg) const { SPre q; const size_t off = (size_t)row * 1024 + 32 * tn + 4 * cg;
        q.x = *(const u32x2*)(Xin + off); q.s = 1.0f; q.p = (u32x2){0u, 0u};
        if (MODE == 1) { q.s = pg8::rstd_of(ssq_in, row - MP); q.p = *(const u32x2*)(PP + off); } return q; }
    __device__ __forceinline__ void apply(int row, int tn, int cg, sf32x4 v, const SPre& q) const {
        const size_t off = (size_t)row * 1024 + 32 * tn + 4 * cg;
        sf32x4 xv = (sf32x4){bflo(q.x.x), bfhi(q.x.x), bflo(q.x.y), bfhi(q.x.y)};
        if (MODE == 1) v = (sf32x4){bflo(q.p.x) * pg8::fast_sigmoid(v[0] * q.s), bfhi(q.p.x) * pg8::fast_sigmoid(v[1] * q.s), bflo(q.p.y) * pg8::fast_sigmoid(v[2] * q.s), bfhi(q.p.y) * pg8::fast_sigmoid(v[3] * q.s)};
        xv = xv + v;
        if (Yf) *(sf32x4*)(Yf + off) = xv;
        u32x2 w; w.x = pkc(xv[0], xv[1]); w.y = pkc(xv[2], xv[3]); *(u32x2*)(XBo + off) = w;
        float ss = (xv[0] * xv[0] + xv[1] * xv[1]) + (xv[2] * xv[2] + xv[3] * xv[3]);
        ss += __shfl_xor(ss, 1); ss += __shfl_xor(ss, 2); ss += __shfl_xor(ss, 4);
        if (cg == 0) atomicAdd(ssq_out + (size_t)(row - MP) * 16 + (tn >> 1), ss);
    }
};
struct STile { const bf16_t* ap; const bf16_t* bp0; const bf16_t* bp1; int tn, row0; };
template <class Epi> __device__ __forceinline__ STile stile_of(const bf16_t* A, const bf16_t* Bt, int K, int kw, int tile, int wv, int i16, int q) {
    STile t; const int tm = tile & 7; t.tn = tile >> 3; t.row0 = 64 * tm;
    int brow0, brow1;
    if (Epi::SWIGLU) { const int pn = t.tn >> 3, i0 = (t.tn & 7) * 16; brow0 = 256 * pn + i0; brow1 = brow0 + 128; } else { brow0 = 32 * t.tn; brow1 = brow0 + 16; }
    t.ap = A + (size_t)(t.row0 + i16) * K + wv * kw + 8 * q; t.bp0 = Bt + (size_t)(brow0 + i16) * K + wv * kw + 8 * q; t.bp1 = Bt + (size_t)(brow1 + i16) * K + wv * kw + 8 * q; return t; }
#define SG_LOADA(T, KS0, a_) do { _Pragma("unroll") for (int kk_ = 0; kk_ < 4; ++kk_) { if ((KS0) + kk_ < nks) { \
        _Pragma("unroll") for (int mt_ = 0; mt_ < 4; ++mt_) a_[kk_][mt_] = *(const bf16x8*)((T).ap + (size_t)(16 * mt_) * K + 32 * ((KS0) + kk_)); } } } while (0)
#define SG_LOADB(T, KS0, b0_, b1_) do { _Pragma("unroll") for (int kk_ = 0; kk_ < 4; ++kk_) { if ((KS0) + kk_ < nks) { \
        b0_[kk_] = *(const bf16x8*)((T).bp0 + 32 * ((KS0) + kk_)); b1_[kk_] = *(const bf16x8*)((T).bp1 + 32 * ((KS0) + kk_)); } } } while (0)
#define SG_MMA(KS0, a_, b0_, b1_) do { _Pragma("unroll") for (int kk_ = 0; kk_ < 4; ++kk_) { if ((KS0) + kk_ < nks) { \
        _Pragma("unroll") for (int mt_ = 0; mt_ < 4; ++mt_) { acc[mt_][0] = __builtin_amdgcn_mfma_f32_16x16x32_bf16(b0_[kk_], a_[kk_][mt_], acc[mt_][0], 0, 0, 0); acc[mt_][1] = __builtin_amdgcn_mfma_f32_16x16x32_bf16(b1_[kk_], a_[kk_][mt_], acc[mt_][1], 0, 0, 0); } } } } while (0)
template <class Epi> __device__ __forceinline__ void sgemm_tiles(Frame& F, const bf16_t* A, const bf16_t* Bt, int N, int K, const Epi& E, int tile0, int tstride) {
    const int lane = F.lane, wv = F.wave, i16 = lane & 15, q = lane >> 4, tid = F.tid, rr = tid >> 3, cg = tid & 7;
    const int ntiles = 8 * (N >> 5), kw = K >> 3, nks = kw >> 5;
    if (tile0 >= ntiles) return;
    const bool keepa = (tstride & 7) == 0;
    LAS float* P = (LAS float*)F.lds;
    bf16x8 fa[4][4], fb0[4], fb1[4];
    STile cur = stile_of<Epi>(A, Bt, K, kw, tile0, wv, i16, q);
    SPre pre = E.prefetch(MP + cur.row0 + rr, cur.tn, cg);
    SG_LOADA(cur, 0, fa); SG_LOADB(cur, 0, fb0, fb1);
    for (int tile = tile0; tile < ntiles; tile += tstride) {
        sf32x4 acc[4][2];
#pragma unroll
        for (int mt = 0; mt < 4; ++mt) { acc[mt][0] = (sf32x4){0.f, 0.f, 0.f, 0.f}; acc[mt][1] = (sf32x4){0.f, 0.f, 0.f, 0.f}; }
        SG_MMA(0, fa, fb0, fb1);
        for (int ks0 = 4; ks0 < nks; ks0 += 4) { bf16x8 ga[4][4], gb0[4], gb1[4]; SG_LOADA(cur, ks0, ga); SG_LOADB(cur, ks0, gb0, gb1); SG_MMA(ks0, ga, gb0, gb1); }
        const int nt = tile + tstride; const bool hn = nt < ntiles;
        const STile nx = stile_of<Epi>(A, Bt, K, kw, hn ? nt : tile, wv, i16, q);
        const SPre cpre = pre;
        if (hn) { pre = E.prefetch(MP + nx.row0 + rr, nx.tn, cg); if (!keepa) SG_LOADA(nx, 0, fa); SG_LOADB(nx, 0, fb0, fb1); }
#pragma unroll
        for (int mt = 0; mt < 4; ++mt) { *(LAS sf32x4*)(P + ((wv * 64 + 16 * mt + i16) * 36 + 4 * q)) = acc[mt][0]; *(LAS sf32x4*)(P + ((wv * 64 + 16 * mt + i16) * 36 + 16 + 4 * q)) = acc[mt][1]; }
        LDS_BARRIER();
        sf32x4 v = (sf32x4){0.f, 0.f, 0.f, 0.f};
#pragma unroll
        for (int w = 0; w < 8; ++w) v = v + *(const LAS sf32x4*)(P + ((w * 64 + rr) * 36 + 4 * cg));
        E.apply(MP + cur.row0 + rr, cur.tn, cg, v, cpre);
        LDS_BARRIER();
        cur = nx;
    }
}
#undef SG_LOADA
#undef SG_LOADB
#undef SG_MMA
template <class Epi> __device__ __forceinline__ void sgemm_tiles_from(Frame& F, const bf16_t* A, const bf16_t* Bt, int N, int K, const Epi& E, int tile0, int tstride) { sgemm_tiles<Epi>(F, A, Bt, N, K, E, tile0, tstride); }
constexpr int PH_P0 = 0, PH_A0 = 1, PH_B0 = 15, NPHASE = 30;

__global__ void __launch_bounds__(NWAVES * 64, 2) mk_fwd(Args args) {
    extern __shared__ __attribute__((aligned(16))) unsigned char lds[];
    Frame F;
    F.lds = (LAS unsigned char*)lds;
    F.tid = threadIdx.x; F.lane = F.tid & 63; F.wave = __builtin_amdgcn_readfirstlane(F.tid >> 6);
    F.G = gridDim.x; { const int bx = blockIdx.x; F.vcu = (F.G % 8 == 0) ? (bx % 8) * (F.G / 8) + bx / 8 : bx; }
    volatile LAS unsigned* MISC = (volatile LAS unsigned*)(F.lds + MISC_OFF);
    for (int u = F.tid; u < (LDS_BYTES - LDSCTL_OFF) / 4; u += NWAVES * 64) ((LAS unsigned*)(F.lds + LDSCTL_OFF))[u] = 0u;
    __syncthreads();
    unsigned* ctl = (unsigned*)(args.ws + WS_CTL);
    XcdBarrier bar; bar.bar = ctl + CW_BAR; bar.x = 0; bar.st = nullptr;
    if (args.use_bar) bar = xcd_barrier_post(ctl + CW_BAR, MISC + 8);
    const int lo = args.ph_lo, hi = args.ph_hi;
#ifndef MK_DUP
#define MK_DUP (-1)
#endif
#define IN(k) (lo <= (k) && (k) < hi)
#define SEAM(k) do { if (IN(k) && IN((k) + 1)) { xcd_barrier(bar); if (MK_DUP == 19) xcd_barrier(bar); } } while (0)
#define DUP(t) for (int dup_ = 0; dup_ < ((MK_DUP == (t)) ? 2 : 1); ++dup_)
    unsigned char* ws = args.ws;
    float* X = args.out + OUT_Y;
    float* SSQM = (float*)(ws + WS_SSQM); float* SSQSA = (float*)(ws + WS_SSQ);
#define SSQP(v) (SSQM + (size_t)(v) * MP * 16)
#define SSQS(v) (SSQSA + (size_t)(v) * MS * 16)
    bf16_t* XB = (bf16_t*)(ws + WS_XB);
    bf16_t* PROJ = (bf16_t*)(ws + WS_PROJ); bf16_t* H = (bf16_t*)(ws + WS_H); bf16_t* ON = (bf16_t*)(ws + WS_ON);
    bf16_t* PP = (bf16_t*)(ws + WS_PP); bf16_t* PB = (bf16_t*)(ws + WS_PB);
    const int bx = (int)blockIdx.x;

    if (IN(PH_P0)) { DUP(0) { p0_prologue(args, F); __syncthreads(); } }
    SEAM(PH_P0);
#define PP_SITE(i, c_, G_) { { SEpiScale SE{PP + (size_t)(i) * MT * 1024, 1024, nullptr, 1 << 30, nullptr, 0}; \
              sgemm_tiles<SEpiScale>(F, PB + ((size_t)(i) * MT + MP) * PLE, (const bf16_t*)(ws + WS_WPROJ) + (size_t)(i) * 1024 * PLE, 1024, PLE, SE, (c_), (G_)); } \
            pg8::Gemm g{PB + (size_t)(i) * MT * PLE, (const bf16_t*)(ws + WS_WPROJ) + (size_t)(i) * 1024 * PLE, MP, 1024, PLE}; pg8::StaticOrder S; S.init(MP, 1024, (G_), (c_)); \
            pg8::EpiScale E{PP + (size_t)(i) * MT * 1024, 1024, nullptr, 1 << 30, nullptr, 0}; \
            pg8::gemm_phase<pg8::EpiScale, pg8::StaticOrder, true, true>(F.lds, g, S, E); }

#define CHANNEL_PHASES(phbase, layer, WoT)                                                                                                   \
    if (IN((phbase) + 0)) {                                                                            \
        { SEpiRes<0> SE{XB, XB + (size_t)1 * MT * D, SSQS(3 * (layer) + 1), nullptr, nullptr, nullptr};                                  \
          sgemm_tiles<SEpiRes<0>>(F, ON + (size_t)MP * D, (WoT), 1024, 1024, SE, bx, F.G); }                                                  \
        pg8::Gemm g{ON, (WoT), MP, 1024, 1024}; pg8::StaticOrder S; S.init(MP, 1024, F.G, bx);                                               \
        pg8::EpiRes<0> E{XB, XB + (size_t)1 * MT * D, SSQP(3 * (layer) + 1), nullptr, nullptr, nullptr};                                  \
        pg8::gemm_phase<pg8::EpiRes<0>, pg8::StaticOrder, true, true>(F.lds, g, S, E); if (MK_DUP == 18) { pg8::EpiScale Ed{(bf16_t*)(ws + WS_OG), 1024, nullptr, 1 << 30, nullptr, 0}; pg8::gemm_phase<pg8::EpiScale, pg8::StaticOrder, true, true>(F.lds, g, S, Ed); } }                                                      \
    SEAM((phbase) + 0);                                                                                                                      \
    if (IN((phbase) + 1)) {                                                                               \
        { SEpiSwiglu SE{H, SSQS(3 * (layer) + 1)};     \
          if (F.G == 256) { if (bx < 128) DUP(15) sgemm_tiles<SEpiSwiglu>(F, XB + ((size_t)1 * MT + MP) * D, (const bf16_t*)(ws + WS_WFIN) + (size_t)(layer) * 5632 * 1024, 1 * 128 * 32 / 8, 1024, SE, bx, 128);   \
              else DUP(15) sgemm_tiles_from<SEpiSwiglu>(F, XB + ((size_t)1 * MT + MP) * D, (const bf16_t*)(ws + WS_WFIN) + (size_t)(layer) * 5632 * 1024, 5632, 1024, SE, 128 + (bx - 128), 128); }                    \
          else DUP(15) sgemm_tiles<SEpiSwiglu>(F, XB + ((size_t)1 * MT + MP) * D, (const bf16_t*)(ws + WS_WFIN) + (size_t)(layer) * 5632 * 1024, 5632, 1024, SE, bx, F.G); }                                           \
        pg8::Gemm g{XB + (size_t)1 * MT * D, (const bf16_t*)(ws + WS_WFIN) + (size_t)(layer) * 5632 * 1024, MP, 5632, 1024}; pg8::StaticOrder S; S.init(MP, 5632, F.G, bx); \
        pg8::EpiSwiglu E{H, FF, SSQP(3 * (layer) + 1)};                                                                       \
        pg8::gemm_phase<pg8::EpiSwiglu, pg8::StaticOrder, true, true>(F.lds, g, S, E); if (MK_DUP == 16) pg8::gemm_phase<pg8::EpiSwiglu, pg8::StaticOrder, true, true>(F.lds, g, S, E); }                                                      \
    SEAM((phbase) + 1);                                                                                                                      \
    if (IN((phbase) + 2)) {                                                                         \
        { SEpiRes<0> SE{XB + (size_t)1 * MT * D, XB + (size_t)2 * MT * D, SSQS(3 * (layer) + 2), nullptr, nullptr, nullptr};                                  \
          sgemm_tiles<SEpiRes<0>>(F, H + (size_t)MP * FF, (const bf16_t*)(ws + WS_WFOUT) + (size_t)(layer) * 1024 * FF, 1024, FF, SE, bx, F.G); } \
        pg8::Gemm g{H, (const bf16_t*)(ws + WS_WFOUT) + (size_t)(layer) * 1024 * FF, MP, 1024, FF}; pg8::StaticOrder S; S.init(MP, 1024, F.G, bx); \
        pg8::EpiRes<0> E{XB + (size_t)1 * MT * D, XB + (size_t)2 * MT * D, SSQP(3 * (layer) + 2), nullptr, nullptr, nullptr};                                  \
        pg8::gemm_phase<pg8::EpiRes<0>, pg8::StaticOrder, true, true>(F.lds, g, S, E); if (MK_DUP == 18) { pg8::EpiScale Ed{(bf16_t*)(ws + WS_OG), 1024, nullptr, 1 << 30, nullptr, 0}; pg8::gemm_phase<pg8::EpiScale, pg8::StaticOrder, true, true>(F.lds, g, S, Ed); } }                                                      \
    SEAM((phbase) + 2);                                                                                                                      \
    if (IN((phbase) + 3)) {                                                      \
        { SEpiRes<1> SE{XB + (size_t)2 * MT * D, XB, SSQS(3 * (layer) + 3), SSQS(3 * (layer) + 2), PP + (size_t)(layer) * MT * 1024, (layer) == 3 ? X : nullptr};   \
          sgemm_tiles<SEpiRes<1>>(F, XB + ((size_t)2 * MT + MP) * D, (const bf16_t*)(ws + WS_WGATE) + (size_t)(layer) * 1024 * 1024, 1024, 1024, SE, bx, F.G); } \
        pg8::Gemm g{XB + (size_t)2 * MT * D, (const bf16_t*)(ws + WS_WGATE) + (size_t)(layer) * 1024 * 1024, MP, 1024, 1024}; pg8::StaticOrder S; S.init(MP, 1024, F.G, bx); \
        pg8::EpiRes<1> E{XB + (size_t)2 * MT * D, XB, SSQP(3 * (layer) + 3), SSQP(3 * (layer) + 2), PP + (size_t)(layer) * MT * 1024, (layer) == 3 ? X : nullptr};   \
        pg8::gemm_phase<pg8::EpiRes<1>, pg8::StaticOrder, true, true>(F.lds, g, S, E); if (MK_DUP == 18) { pg8::EpiScale Ed{(bf16_t*)(ws + WS_OG), 1024, nullptr, 1 << 30, nullptr, 0}; pg8::gemm_phase<pg8::EpiScale, pg8::StaticOrder, true, true>(F.lds, g, S, Ed); } }                                                      \
    SEAM((phbase) + 3);

#if !defined(NO_A)
#define A_LAYER(LIDX) { \
        constexpr int l = LIDX; constexpr int pb = PH_A0 + 7 * l; \
        if (IN(pb + 0)) { \
            { SEpiScale SE{PROJ, NPROJ, SSQS(3 * l), 1 << 30, nullptr, 0}; \
              DUP(15) sgemm_tiles<SEpiScale>(F, XB + (size_t)MP * D, (const bf16_t*)(ws + WS_WIN) + (size_t)l * 3072 * 1024, 3072, 1024, SE, bx, F.G); } \
            pg8::Gemm g{XB, (const bf16_t*)(ws + WS_WIN) + (size_t)l * 3072 * 1024, MP, 3072, 1024}; pg8::StaticOrder S; S.init(MP, 3072, F.G, bx); \
            pg8::EpiScale E{PROJ, NPROJ, SSQP(3 * l), 1 << 30, nullptr, 0}; \
            pg8::gemm_phase<pg8::EpiScale, pg8::StaticOrder, true, true>(F.lds, g, S, E); if (MK_DUP == 16) pg8::gemm_phase<pg8::EpiScale, pg8::StaticOrder, true, true>(F.lds, g, S, E); \
            DUP(14) glr_rows(args, F, l, XB, SSQP(3 * l), SSQS(3 * l)); \
        } \
        SEAM(pb + 0); \
        if (IN(pb + 1)) { \
            DUP(11) for (int it = bx; it < 256; it += F.G) gla_g1_item(args, F, l, it); \
        } \
        SEAM(pb + 1); \
        if (IN(pb + 2)) { \
            for (int bh = bx; bh < 32; bh += F.G) gla_g2_seq(args, F, l, bh); \
            const int ns = F.G > 32 ? F.G - 32 : F.G, sb0 = F.G > 32 ? bx - 32 : bx; \
            if (sb0 >= 0) { DUP(12) for (int it = sb0; it < 512; it += ns) gla_naive_item(args, F, l, it); \
                DUP(17) cache_compact(args, F, l, sb0 * NWAVES + F.wave, ns * NWAVES); \
                __syncthreads(); \
                PP_SITE(2 * l, sb0, ns) PP_SITE(2 * l + 1, sb0, ns) } \
        } \
        SEAM(pb + 2); \
        if (MK_DUP == 3 && IN(pb + 1) && IN(pb + 2)) { \
            for (int it = bx; it < 256; it += F.G) gla_g1_item(args, F, l, it); \
            xcd_barrier(bar); \
            for (int bh = bx; bh < 32; bh += F.G) gla_g2_seq(args, F, l, bh); \
            xcd_barrier(bar); \
        } \
        CHANNEL_PHASES(pb + 3, l, (const bf16_t*)(ws + WS_WAO) + (size_t)l * 1024 * 1024) }
    A_LAYER(0)
    A_LAYER(1)
#undef A_LAYER
#endif
#if !defined(NO_B)
#define B_LAYER(JIDX) { \
        constexpr int j = JIDX; constexpr int pb = PH_B0 + 8 * j, layer = 2 + j; constexpr int pa = pb + 1 - j;     \
        if (IN(pb + 0)) { \
            if (j == 0) { \
                { SEpiScale SE{PROJ, NPROJ, SSQS(3 * layer), 3072, (float*)(ws + WS_KVRAW), 1024}; \
                  DUP(15) sgemm_tiles<SEpiScale>(F, XB + (size_t)MP * D, (const bf16_t*)(ws + WS_WQKV), 4096, 1024, SE, bx, F.G); } \
                pg8::Gemm g{XB, (const bf16_t*)(ws + WS_WQKV), MP, 4096, 1024}; pg8::StaticOrder S; S.init(MP, 4096, F.G, bx); \
                pg8::EpiScale E{PROJ, NPROJ, SSQP(3 * layer), 12, (float*)(ws + WS_KVRAW), 1024}; \
                pg8::gemm_phase<pg8::EpiScale, pg8::StaticOrder, true, true>(F.lds, g, S, E); if (MK_DUP == 16) pg8::gemm_phase<pg8::EpiScale, pg8::StaticOrder, true, true>(F.lds, g, S, E); \
            } else { \
                { SEpiScale SE{PROJ, NPROJ, SSQS(3 * layer), 1 << 30, nullptr, 0}; \
                  DUP(15) sgemm_tiles<SEpiScale>(F, XB + (size_t)MP * D, (const bf16_t*)(ws + WS_WQ1), 3072, 1024, SE, bx, F.G); } \
                pg8::Gemm g{XB, (const bf16_t*)(ws + WS_WQ1), MP, 3072, 1024}; pg8::StaticOrder S; S.init(MP, 3072, F.G, bx); \
                pg8::EpiScale E{PROJ, NPROJ, SSQP(3 * layer), 1 << 30, nullptr, 0}; \
                pg8::gemm_phase<pg8::EpiScale, pg8::StaticOrder, true, true>(F.lds, g, S, E); if (MK_DUP == 16) pg8::gemm_phase<pg8::EpiScale, pg8::StaticOrder, true, true>(F.lds, g, S, E); \
            } \
        } \
        SEAM(pb + 0); \
        if (j == 0) { if (IN(pb + 1)) { DUP(6) { kn_rows(args, F); vt_build(args, F); } } \
            SEAM(pb + 1); } \
        if (IN(pa + 1)) { DUP(4) for (int v = F.vcu; v < 1024; v += F.G) att_unit<false>(args, F, j, v < 512 ? v : v + 512);     DUP(13) for (int it = bx; it < 256; it += F.G) satt_item(args, F, j, it); } \
        SEAM(pa + 1); \
        if (IN(pa + 2)) { DUP(5) for (int un = 512 + F.vcu; un < 1024; un += F.G) att_unit<true>(args, F, j, un);     DUP(13) for (int it = 256 + bx; it < 512; it += F.G) satt_item(args, F, j, it); } \
        SEAM(pa + 2); \
        CHANNEL_PHASES(pa + 3, layer, (const bf16_t*)(ws + WS_WBO) + (size_t)j * 1024 * 1024) }
    B_LAYER(0)
    B_LAYER(1)
#undef B_LAYER
#endif
#undef CHANNEL_PHASES
#undef IN
#undef SEAM
}
}

#ifndef MK_ONE_LAUNCH
#define MK_ONE_LAUNCH 0
#endif
extern "C" void kernel_launch(void* const* d_in, const int* in_sizes, int n_in, void* d_out, int out_size, void* d_ws, size_t ws_size, hipStream_t stream) {
    using namespace mk;
    static int grid = 0;
    if (grid == 0) {
        if (n_in != 26 || out_size != 70254592 || ws_size < WS_END) { fprintf(stderr, "kernel_launch: unexpected problem shape (n_in %d, out %d, ws %zu, need %zu)\n", n_in, out_size, ws_size, (size_t)WS_END); grid = -1; return; }
        int dev = 0, cus = 0, per_cu = 0;
        if (hipGetDevice(&dev) != hipSuccess || hipDeviceGetAttribute(&cus, hipDeviceAttributeMultiprocessorCount, dev) != hipSuccess) { grid = -1; return; }
        if (hipFuncSetAttribute((const void*)mk_fwd, hipFuncAttributeMaxDynamicSharedMemorySize, LDS_BYTES) != hipSuccess) { fprintf(stderr, "kernel_launch: hipFuncSetAttribute failed\n"); grid = -1; return; }
        if (hipOccupancyMaxActiveBlocksPerMultiprocessor(&per_cu, (const void*)mk_fwd, NWAVES * 64, LDS_BYTES) != hipSuccess || per_cu < 1) { fprintf(stderr, "kernel_launch: occupancy query says %d\n", per_cu); }
        (void)hipGetLastError();
        grid = cus;
    }
    if (grid < 0) return;
    if (hipMemsetAsync((char*)d_ws + WS_CTL, 0, CTL_BYTES, stream) != hipSuccess) return;
    Args a{};
    for (int i = 0; i < 26; ++i) a.in[i] = (const float*)d_in[i];
    a.out = (float*)d_out; a.ws = (unsigned char*)d_ws;
#if MK_ONE_LAUNCH
    a.ph_lo = 0; a.ph_hi = NPHASE; a.use_bar = 1; a.pad = 0;
    hipLaunchKernelGGL(mk_fwd, dim3(grid), dim3(NWAVES * 64), LDS_BYTES, stream, a);
#else
    for (int p = 0; p < NPHASE; ++p) { a.ph_lo = p; a.ph_hi = p + 1; a.use_bar = 0; a.pad = 0;
        hipLaunchKernelGGL(mk_fwd, dim3(grid), dim3(NWAVES * 64), LDS_BYTES, stream, a); }
#endif
}
```
